# Optimizing an MI355X kernel written in HIP

```python
import jax, jax.numpy as jnp
from jax import lax
import numpy as np

D_MODEL = 1024
BATCH = 8
SEQ = 8192
DEPTH = 2
DEC_BATCH = 16
DEC_SEQ = 4096
PAST_LEN = 128

HEAD_DIM = 64
N_HEADS = D_MODEL // HEAD_DIM
A_Q_HEADS = N_HEADS // 2
A_KV_HEADS = 2
B_HEADS = N_HEADS - A_Q_HEADS
C_HEADS = N_HEADS
A_Q = A_Q_HEADS * HEAD_DIM
A_KV = A_KV_HEADS * HEAD_DIM
B_W = B_HEADS * HEAD_DIM
W_IN_EVEN = A_Q + 2 * A_KV + 3 * B_W
W_MIX_EVEN = A_Q + B_W
C_W = C_HEADS * HEAD_DIM
W_IN_ODD = 3 * C_W
GRID_W = 64
NA_ROWS = 8
NA_COLS = 16
C_GROUPS = ((128, 1), (512, 4), (2048, 16))
Q_BLOCK = 128
ROPE_THETA = 10000.0
D_FF = -(-8 * D_MODEL // (3 * 256)) * 256
N_EVEN = (DEPTH + 1) // 2
N_ODD = DEPTH // 2
EPS = 1e-6
NEG = -1e30

kernel_name = "hybrid_bidir_axial_gqa_natten_dilated_encoder"


def _rmsnorm(x, g):
    xf = x.astype(jnp.float32)
    y = xf * lax.rsqrt(jnp.mean(xf * xf, axis=-1, keepdims=True) + EPS)
    return (y * g.astype(jnp.float32)).astype(x.dtype)


def _rope_1d(x, pos):
    n = x.shape[-1] // 2
    freqs = jnp.power(ROPE_THETA, -jnp.arange(n, dtype=jnp.float32) / n)
    ang = pos.astype(jnp.float32)[:, None] * freqs[None, :]
    cos = jnp.cos(ang)[:, None, :]
    sin = jnp.sin(ang)[:, None, :]
    xf = x.astype(jnp.float32)
    x1, x2 = xf[..., :n], xf[..., n:]
    return jnp.concatenate([x1 * cos - x2 * sin, x1 * sin + x2 * cos], axis=-1).astype(x.dtype)


def _axial_rope(x, seq):
    t = jnp.arange(seq)
    half = HEAD_DIM // 2
    return jnp.concatenate([_rope_1d(x[..., :half], t // GRID_W),
                            _rope_1d(x[..., half:], t % GRID_W)], axis=-1)


def _mixer_axial_gqa(q, k, v, gq, gk):
    bn, seq = q.shape[0], q.shape[1]
    q = _axial_rope(_rmsnorm(q, gq), seq)
    k = _axial_rope(_rmsnorm(k, gk), seq)
    grp = A_Q_HEADS // A_KV_HEADS
    nb = seq // Q_BLOCK
    qb = q.reshape(bn, nb, Q_BLOCK, A_KV_HEADS, grp, HEAD_DIM).transpose(1, 0, 2, 3, 4, 5)
    scale = HEAD_DIM ** -0.5

    def one_block(qblk):
        s = jnp.einsum('bqkgd,bskd->bkgqs', qblk, k).astype(jnp.float32) * scale
        p = jax.nn.softmax(s, axis=-1)
        return jnp.einsum('bkgqs,bskd->bqkgd', p.astype(v.dtype), v)

    o = lax.map(one_block, qb)
    return o.transpose(1, 0, 2, 3, 4, 5).reshape(bn, seq, A_Q)


def _mixer_neighbourhood(q, k, v, rpb):
    bn, seq = q.shape[0], q.shape[1]
    rows = seq // GRID_W
    wr = min(NA_ROWS, rows)
    r = jnp.arange(rows)
    rs = jnp.clip(r - wr // 2, 0, rows - wr)
    row_idx = rs[:, None] + jnp.arange(wr)[None, :]

    def grid(a):
        return a.reshape(bn, rows, GRID_W, B_HEADS, HEAD_DIM)

    kg = grid(k)[:, row_idx].reshape(bn, rows, wr * GRID_W, B_HEADS, HEAD_DIM)
    vg = grid(v)[:, row_idx].reshape(bn, rows, wr * GRID_W, B_HEADS, HEAD_DIM)
    s = jnp.einsum('brqhd,brkhd->brhqk', grid(q), kg).astype(jnp.float32) * (HEAD_DIM ** -0.5)
    c = jnp.arange(GRID_W)
    cs = jnp.clip(c - NA_COLS // 2, 0, GRID_W - NA_COLS)
    col_ok = (c[None, :] >= cs[:, None]) & (c[None, :] < cs[:, None] + NA_COLS)
    dr = row_idx - r[:, None] + (NA_ROWS - 1)
    dc = jnp.clip(c[None, :] - c[:, None] + (NA_COLS - 1), 0, 2 * NA_COLS - 2)
    bias = rpb[:, dr[:, None, :, None], dc[None, :, None, :]]
    bias = bias.transpose(1, 0, 2, 3, 4).reshape(rows, B_HEADS, GRID_W, wr * GRID_W).astype(jnp.float32)
    mask = jnp.tile(col_ok, (1, wr))
    s = jnp.where(mask, s + bias[None], NEG)
    p = jax.nn.softmax(s, axis=-1)
    o = jnp.einsum('brhqk,brkhd->brqhd', p.astype(v.dtype), vg)
    return o.reshape(bn, seq, B_W)


def _band_attn(q, k, v, half, slope):
    n, length = q.shape[0], q.shape[1]
    kb_len = Q_BLOCK + 2 * half
    nb = -(-length // Q_BLOCK)
    lp = nb * Q_BLOCK
    qp = jnp.pad(q, ((0, 0), (0, lp - length), (0, 0), (0, 0)))
    kp = jnp.pad(k, ((0, 0), (half, lp - length + half), (0, 0), (0, 0)))
    vp = jnp.pad(v, ((0, 0), (half, lp - length + half), (0, 0), (0, 0)))
    blk = jnp.arange(nb)[:, None] * Q_BLOCK + jnp.arange(kb_len)[None, :]
    kb = kp[:, blk]
    vb = vp[:, blk]
    qb = qp.reshape(n, nb, Q_BLOCK, q.shape[2], HEAD_DIM)
    s = jnp.einsum('nbqhd,nbkhd->nbhqk', qb, kb).astype(jnp.float32) * (HEAD_DIM ** -0.5)
    qi = jnp.arange(nb)[:, None] * Q_BLOCK + jnp.arange(Q_BLOCK)[None, :]
    kj = jnp.arange(nb)[:, None] * Q_BLOCK - half + jnp.arange(kb_len)[None, :]
    dist = jnp.abs(qi[:, :, None] - kj[:, None, :])
    valid = ((kj >= 0) & (kj < length))[:, None, :] & (dist <= half)
    s = s - slope[None, :, None, None] * dist[:, None, :, :].astype(jnp.float32)
    s = jnp.where(valid[:, None], s, NEG)
    m = jnp.max(s, axis=-1, keepdims=True)
    e = jnp.exp(s - m)
    den = jnp.sum(e, axis=-1, keepdims=True)
    lse = (m + jnp.log(den))[..., 0]
    p = e / den
    o = jnp.einsum('nbhqk,nbkhd->nbqhd', p.astype(v.dtype), vb).reshape(n, lp, q.shape[2], HEAD_DIM)[:, :length]
    lse = lse.transpose(0, 1, 3, 2).reshape(n, lp, q.shape[2])[:, :length]
    return o, lse


def _dilated_group(q, k, v, dil, half, slopes):
    bn, seq, h = q.shape[0], q.shape[1], q.shape[2]
    length = seq // dil

    def fold(a):
        return a.reshape(bn, length, dil, h, HEAD_DIM).transpose(0, 2, 1, 3, 4).reshape(bn * dil, length, h, HEAD_DIM)

    o, lse = _band_attn(fold(q), fold(k), fold(v), half, slopes * dil)
    o = o.reshape(bn, dil, length, h, HEAD_DIM).transpose(0, 2, 1, 3, 4).reshape(bn, seq, h, HEAD_DIM)
    lse = lse.reshape(bn, dil, length, h).transpose(0, 2, 1, 3).reshape(bn, seq, h)
    return o, lse


def _mixer_dilated(hn, w_in, w_out):
    bn, seq = hn.shape[0], hn.shape[1]
    qkv = (hn @ w_in).reshape(bn, seq, 3, C_HEADS, HEAD_DIM)
    q, k, v = qkv[:, :, 0], qkv[:, :, 1], qkv[:, :, 2]
    slopes = jnp.exp2(-8.0 * (jnp.arange(C_HEADS, dtype=jnp.float32) + 1.0) / C_HEADS)
    outs, lses = [], []
    for window, dil in C_GROUPS:
        o, l = _dilated_group(q, k, v, dil, window // (2 * dil), slopes)
        outs.append(o)
        lses.append(l)
    wts = jax.nn.softmax(jnp.stack(lses, axis=0), axis=0)
    o = jnp.sum(wts[..., None] * jnp.stack(outs, axis=0).astype(jnp.float32), axis=0).astype(hn.dtype)
    return o.reshape(bn, seq, C_W) @ w_out


def _mixer_even(hn, w_in, gq, gk, rpb, w_out):
    bn, seq = hn.shape[0], hn.shape[1]
    p = hn @ w_in
    cuts = [A_Q, A_Q + A_KV, A_Q + 2 * A_KV, A_Q + 2 * A_KV + B_W, A_Q + 2 * A_KV + 2 * B_W]
    qa, ka, va, qb, kb, vb = jnp.split(p, cuts, axis=-1)
    oa = _mixer_axial_gqa(qa.reshape(bn, seq, A_Q_HEADS, HEAD_DIM),
                          ka.reshape(bn, seq, A_KV_HEADS, HEAD_DIM),
                          va.reshape(bn, seq, A_KV_HEADS, HEAD_DIM), gq, gk)
    ob = _mixer_neighbourhood(qb.reshape(bn, seq, B_HEADS, HEAD_DIM),
                              kb.reshape(bn, seq, B_HEADS, HEAD_DIM),
                              vb.reshape(bn, seq, B_HEADS, HEAD_DIM), rpb)
    return jnp.concatenate([oa, ob], axis=-1) @ w_out


def _swiglu(hn, w_gu, w_dn):
    g, u = jnp.split(hn @ w_gu, 2, axis=-1)
    return (jax.nn.silu(g) * u) @ w_dn


def _trunk(x, norm_mix, norm_ffn, norm_final, w_in_even, a_q_norm, a_k_norm, na_rpb,
           w_out_even, w_in_odd, w_out_odd, w_gate_up, w_down):
    for i in range(DEPTH):
        hn = _rmsnorm(x, norm_mix[i])
        j = i // 2
        if i % 2 == 0:
            mix = _mixer_even(hn, w_in_even[j], a_q_norm[j], a_k_norm[j], na_rpb[j], w_out_even[j])
        else:
            mix = _mixer_dilated(hn, w_in_odd[j], w_out_odd[j])
        x = x + mix.astype(x.dtype)
        x = x + _swiglu(_rmsnorm(x, norm_ffn[i]), w_gate_up[i], w_down[i]).astype(x.dtype)
    return _rmsnorm(x, norm_final)


def setup_inputs(seed: int = 0) -> dict:
    key = jax.random.key(seed)
    ks = jax.random.split(key, 16)
    f32 = jnp.float32
    nrm = lambda k, s: jax.random.normal(k, s, dtype=f32)
    return {
        "x_prompt": nrm(ks[0], (BATCH, SEQ, D_MODEL)),
        "x_sample": nrm(ks[1], (DEC_BATCH, DEC_SEQ, D_MODEL)),
        "norm_mix": 1.0 + 0.02 * nrm(ks[2], (DEPTH, D_MODEL)),
        "norm_ffn": 1.0 + 0.02 * nrm(ks[3], (DEPTH, D_MODEL)),
        "norm_final": 1.0 + 0.02 * nrm(ks[4], (D_MODEL,)),
        "w_in_even": nrm(ks[5], (N_EVEN, D_MODEL, W_IN_EVEN)) * D_MODEL ** -0.5,
        "a_q_norm": 1.0 + 0.02 * nrm(ks[6], (N_EVEN, HEAD_DIM)),
        "a_k_norm": 1.0 + 0.02 * nrm(ks[7], (N_EVEN, HEAD_DIM)),
        "na_rpb": 0.1 * nrm(ks[8], (N_EVEN, B_HEADS, 2 * NA_ROWS - 1, 2 * NA_COLS - 1)),
        "w_out_even": nrm(ks[9], (N_EVEN, W_MIX_EVEN, D_MODEL)) * W_MIX_EVEN ** -0.5,
        "w_in_odd": nrm(ks[10], (N_ODD, D_MODEL, W_IN_ODD)) * D_MODEL ** -0.5,
        "w_out_odd": nrm(ks[11], (N_ODD, C_W, D_MODEL)) * C_W ** -0.5,
        "w_gate_up": nrm(ks[12], (DEPTH, D_MODEL, 2 * D_FF)) * D_MODEL ** -0.5,
        "w_down": nrm(ks[13], (DEPTH, D_FF, D_MODEL)) * D_FF ** -0.5,
    }


def reference(x_prompt, x_sample, norm_mix, norm_ffn, norm_final, w_in_even, a_q_norm, a_k_norm,
              na_rpb, w_out_even, w_in_odd, w_out_odd, w_gate_up, w_down):
    y_prompt = _trunk(x_prompt, norm_mix, norm_ffn, norm_final, w_in_even, a_q_norm, a_k_norm, na_rpb,
                      w_out_even, w_in_odd, w_out_odd, w_gate_up, w_down)
    y_sample = _trunk(x_sample, norm_mix, norm_ffn, norm_final, w_in_even, a_q_norm, a_k_norm, na_rpb,
                      w_out_even, w_in_odd, w_out_odd, w_gate_up, w_down)
    return (y_prompt, y_sample)
```

```cpp
#include <hip/hip_runtime.h>
#include <hip/hip_cooperative_groups.h>
#include <cstdio>
#include <cstdint>
namespace cg = cooperative_groups;

#define LAS __attribute__((address_space(3)))
typedef unsigned short bf16_t;
typedef short bf16x8 __attribute__((ext_vector_type(8)));
typedef short s16x4 __attribute__((ext_vector_type(4)));
typedef float f32x2 __attribute__((ext_vector_type(2)));
typedef float f32x4 __attribute__((ext_vector_type(4)));
typedef float f32x16 __attribute__((ext_vector_type(16)));
typedef unsigned u32x2 __attribute__((ext_vector_type(2)));
typedef unsigned u32x4 __attribute__((ext_vector_type(4)));
typedef __bf16 bf16x2_t __attribute__((ext_vector_type(2)));

constexpr int DM = 1024, DFF = 2816, RC = 65536;
constexpr int NE = 2304, NO = 3072, NGU = 5632;
constexpr int NEP = NE + 64, NOP = NO + 64;
constexpr float EPS = 1e-6f, LOG2E = 1.4426950408889634f, C2 = 0.125f * 1.4426950408889634f;
constexpr int NTHREADS = 512, NWAVES = 8;
#ifndef PHM
#define PHM 127
#endif
#ifndef DUP
#define DUP 0
#endif

constexpr size_t MiB = 1u << 20;
constexpr size_t WS_ROPE = 0;
constexpr size_t WS_BAR = 65536;
constexpr size_t WS_SSQ = 1 * MiB;
constexpr size_t WS_W = 4 * MiB;
constexpr size_t W_INE = WS_W, W_OUTE = W_INE + (size_t)NE * DM * 2, W_INO = W_OUTE + (size_t)DM * DM * 2, W_OUTO = W_INO + (size_t)NO * DM * 2;
constexpr size_t W_GU0 = W_OUTO + (size_t)DM * DM * 2, W_GU1 = W_GU0 + (size_t)NGU * DM * 2, W_DN0 = W_GU1 + (size_t)NGU * DM * 2, W_DN1 = W_DN0 + (size_t)DM * DFF * 2;
constexpr size_t W_END = W_DN1 + (size_t)DM * DFF * 2;
constexpr size_t WS_XB = 52 * MiB;
constexpr size_t WS_QKV = 180 * MiB;
constexpr size_t WS_H = 180 * MiB;
constexpr size_t WS_O = 576 * MiB;
constexpr size_t WS_XB1 = 704 * MiB;
constexpr size_t WS_LSE = 832 * MiB;
constexpr size_t WS_END = 836 * MiB;
static_assert(W_END <= WS_XB, "weights fit");
static_assert(WS_QKV + (size_t)RC * NOP * 2 <= WS_O && WS_H + (size_t)RC * DFF * 2 <= WS_O, "qkv/h fit");

constexpr int RING_BYTES = 131072;
constexpr int WSF_OFF = RING_BYTES;
constexpr int RPB_OFF = WSF_OFF + 2048;
constexpr int PTAB_OFF = 148736;
constexpr int LDS_BYTES = 151552;
static_assert(RPB_OFF + 3720 * 4 + 512 <= PTAB_OFF && PTAB_OFF + 128 <= LDS_BYTES, "lds map");
__device__ __forceinline__ const float* ldptr(LAS const unsigned long long* tab, int i) {
    const unsigned long long v = tab[i];
    const unsigned lo = __builtin_amdgcn_readfirstlane((unsigned)v), hi = __builtin_amdgcn_readfirstlane((unsigned)(v >> 32));
    return (const float*)(((unsigned long long)hi << 32) | lo);
}

__device__ __forceinline__ unsigned cvtpk(float lo, float hi) { f32x2 v = {lo, hi}; bf16x2_t b = __builtin_convertvector(v, bf16x2_t); return __builtin_bit_cast(unsigned, b); }
__device__ __forceinline__ float bf2f(unsigned short h) { return __builtin_bit_cast(float, (unsigned)h << 16); }
__device__ __forceinline__ float wave_sum(float v) {
#pragma unroll
    for (int o = 1; o < 64; o <<= 1) v += __shfl_xor(v, o);
    return v;
}

namespace pg8 {
constexpr int BM = 256, BK = 64, HALF = 128, HTB = HALF * BK * 2, STAGE_BYTES = 8 * HTB, NXCD = 8, WGM = 8;
__host__ __device__ __forceinline__ int lds_byte(int r, int c) { const int st = (r >> 4) * 2 + (c >> 5), rr = r & 15, cc = c & 31, ob = rr * 64 + cc * 2; return st * 1024 + (ob ^ (((ob >> 9) & 1) << 5)); }
__host__ __device__ __forceinline__ void stage_rc(int b, int& R, int& C) { const int st = b / 1024, sb = b % 1024, swz = sb ^ (((sb >> 9) & 1) << 5); R = (st >> 1) * 16 + swz / 64; C = (st & 1) * 32 + (swz % 64) / 2; }
__host__ __device__ __forceinline__ int perm32(int rho) { const int n = rho >> 4, i = rho & 15; return 8 * (i >> 2) + 4 * n + (i & 3); }
struct Unit { int pm, pn; };
struct Gemm { const bf16_t* A; const bf16_t* Bt; int M, N, K; };
struct StaticOrder {
    int nM, nN, nwg, G, c;
    __host__ __device__ void init(int M, int N, int G_, int c_) { nM = M / BM; nN = N / BM; nwg = nM * nN; G = G_; c = c_; }
    __host__ __device__ bool next(int i, Unit& u) const {
        const long L = (long)i * G + c; if (L >= nwg) return false;
        int wgid = (int)L; { const int q = nwg / NXCD, r = nwg % NXCD, xcd = wgid % NXCD, off = wgid / NXCD; wgid = (xcd < r ? xcd * (q + 1) : r * (q + 1) + (xcd - r) * q) + off; }
        const int nig = WGM * nN, gid = wgid / nig, fm = gid * WGM, gsz = (nM - fm) < WGM ? (nM - fm) : WGM;
        u.pm = fm + ((wgid % nig) % gsz); u.pn = (wgid % nig) / gsz; return true;
    }
};

struct EpiScaleBf16 {
    static constexpr bool PERM = true;
    bf16_t* O; int ldc; const float* ssq; int t0, t1; float tscale;
    __device__ __forceinline__ void pre(const Unit& u, int wr, int fr, float (&pv)[8]) const {
        const int row0 = u.pm * BM + wr * 64 + fr;
#pragma unroll
        for (int i = 0; i < 8; ++i) pv[i] = ssq[row0 + (i >> 2) * HALF + (i & 3) * 16];
    }
    __device__ __forceinline__ void operator()(const f32x4 (&acc)[2][2][4][2], const Unit& u, int wr, int wc, int fr, int fq, const float (&pv)[8]) const {
        const int row0 = u.pm * BM + wr * 64 + fr, col0 = u.pn * BM + wc * 32 + 8 * fq;
        const float sc = (u.pn >= t0 && u.pn < t1) ? tscale : 1.f;
#pragma unroll
        for (int ai = 0; ai < 2; ++ai)
#pragma unroll
            for (int m = 0; m < 4; ++m) { const int row = row0 + ai * HALF + m * 16; const float rs = __builtin_amdgcn_rsqf(pv[ai * 4 + m] * (1.f / DM) + EPS) * sc;
                bf16_t* rowp = O + (size_t)row * ldc + col0;
#pragma unroll
                for (int bj = 0; bj < 2; ++bj) { const f32x4 v0 = acc[ai][bj][m][0] * rs, v1 = acc[ai][bj][m][1] * rs;
                    u32x4 w; w.x = cvtpk(v0[0], v0[1]); w.y = cvtpk(v0[2], v0[3]); w.z = cvtpk(v1[0], v1[1]); w.w = cvtpk(v1[2], v1[3]);
                    *(u32x4*)(rowp + bj * HALF) = w; } }
    }
};
struct EpiSwiGLU {
    static constexpr bool PERM = true;
    bf16_t* H; const float* ssq;
    __device__ __forceinline__ void pre(const Unit& u, int wr, int fr, float (&pv)[8]) const {
        const int row0 = u.pm * BM + wr * 64 + fr;
#pragma unroll
        for (int i = 0; i < 8; ++i) pv[i] = ssq[row0 + (i >> 2) * HALF + (i & 3) * 16];
    }
    __device__ __forceinline__ void operator()(const f32x4 (&acc)[2][2][4][2], const Unit& u, int wr, int wc, int fr, int fq, const float (&pv)[8]) const {
        const int row0 = u.pm * BM + wr * 64 + fr, col0 = u.pn * HALF + wc * 32 + 8 * fq;
#pragma unroll
        for (int ai = 0; ai < 2; ++ai)
#pragma unroll
            for (int m = 0; m < 4; ++m) { const int row = row0 + ai * HALF + m * 16; const float rs = __builtin_amdgcn_rsqf(pv[ai * 4 + m] * (1.f / DM) + EPS);
                float hv[8];
#pragma unroll
                for (int n = 0; n < 2; ++n)
#pragma unroll
                    for (int j = 0; j < 4; ++j) { const float g = acc[ai][0][m][n][j] * rs, uu = acc[ai][1][m][n][j] * rs;
                        const float e = __builtin_amdgcn_exp2f(-g * LOG2E); hv[n * 4 + j] = g * uu * __builtin_amdgcn_rcpf(1.f + e); }
                u32x4 w; w.x = cvtpk(hv[0], hv[1]); w.y = cvtpk(hv[2], hv[3]); w.z = cvtpk(hv[4], hv[5]); w.w = cvtpk(hv[6], hv[7]);
                *(u32x4*)(H + (size_t)row * DFF + col0) = w; }
    }
};
struct EpiResidual {
    static constexpr bool PERM = true;
    bf16_t* xb; float* ssq;
    __device__ __forceinline__ void pre(const Unit&, int, int, float (&)[8]) const {}
    __device__ __forceinline__ void operator()(const f32x4 (&acc)[2][2][4][2], const Unit& u, int wr, int wc, int fr, int fq, const float (&)[8]) const {
        const int row0 = u.pm * BM + wr * 64 + fr, col0 = u.pn * BM + wc * 32 + 8 * fq;
#pragma unroll
        for (int ai = 0; ai < 2; ++ai)
#pragma unroll
            for (int m = 0; m < 4; ++m) { const int row = row0 + ai * HALF + m * 16; bf16_t* rowp = xb + (size_t)row * DM + col0; float s = 0.f;
                u32x4 raw[2];
#pragma unroll
                for (int bj = 0; bj < 2; ++bj) raw[bj] = *(const u32x4*)(rowp + bj * HALF);
#pragma unroll
                for (int bj = 0; bj < 2; ++bj) { const f32x4 a0 = acc[ai][bj][m][0], a1 = acc[ai][bj][m][1]; const u32x4 r = raw[bj];
                    const float x0 = __builtin_bit_cast(float, r.x << 16) + a0[0], x1 = __builtin_bit_cast(float, r.x & 0xffff0000u) + a0[1];
                    const float x2 = __builtin_bit_cast(float, r.y << 16) + a0[2], x3 = __builtin_bit_cast(float, r.y & 0xffff0000u) + a0[3];
                    const float x4 = __builtin_bit_cast(float, r.z << 16) + a1[0], x5 = __builtin_bit_cast(float, r.z & 0xffff0000u) + a1[1];
                    const float x6 = __builtin_bit_cast(float, r.w << 16) + a1[2], x7 = __builtin_bit_cast(float, r.w & 0xffff0000u) + a1[3];
                    u32x4 w; w.x = cvtpk(x0, x1); w.y = cvtpk(x2, x3); w.z = cvtpk(x4, x5); w.w = cvtpk(x6, x7);
                    *(u32x4*)(rowp + bj * HALF) = w;
                    s += ((x0 * x0 + x1 * x1) + (x2 * x2 + x3 * x3)) + ((x4 * x4 + x5 * x5) + (x6 * x6 + x7 * x7)); }
                s += __shfl_xor(s, 16); s += __shfl_xor(s, 32);
                if (fq == 0) atomicAdd(ssq + row, s); }
    }
};

template <class Epi>
__device__ __forceinline__ void gemm_phase(LAS unsigned char* lds, const Gemm g, const StaticOrder& S, const Epi& E, const int wave_id) {
    int tid = threadIdx.x; asm volatile("" : "+v"(tid));
    const int wid = __builtin_amdgcn_readfirstlane(tid >> 6), lane = tid & 63, wr = wid >> 2, wc = wid & 3, fr = lane & 15, fq = lane >> 4;
    const int K = g.K, nt = K / BK;
    unsigned voffA[2], voffB[2];
#pragma unroll
    for (int i = 0; i < 2; ++i) { int R, C; stage_rc(tid * 16 + i * 8192, R, C); const int Rb = Epi::PERM ? ((R & ~31) + perm32(R & 31)) : R;
        voffA[i] = (unsigned)(R * K + C) * 2u; voffB[i] = (unsigned)(Rb * K + C) * 2u; }
    const size_t kstep = (size_t)(BK * 2);
    const size_t hstep = (size_t)HALF * K * 2;
    const size_t tstep = 2 * hstep;
    const unsigned ldsw = (unsigned)wid * 1024u;
    const int aoff = lds_byte(wr * 64 + fr, fq * 8), boff = lds_byte(wc * 32 + fr, fq * 8);
#define PG8_SA(b, h) (((b) * 2 + (h)) * HTB)
#define PG8_SB(b, h) ((4 + (b) * 2 + (h)) * HTB)
#define PG8_STAGE(bufoff, gbase, voff) do { _Pragma("unroll") for (int _i = 0; _i < 2; ++_i) \
        __builtin_amdgcn_global_load_lds((const unsigned*)((const char*)(gbase) + (voff)[_i]), (LAS unsigned*)(lds + (bufoff) + ldsw + _i * 8192), 16, 0, 0); } while (0)
#define PG8_LDA(dst, b, h) do { _Pragma("unroll") for (int m = 0; m < 4; ++m) _Pragma("unroll") for (int k = 0; k < 2; ++k) dst[m][k] = *(const LAS bf16x8*)(lds + PG8_SA(b, h) + aoff + m * 2048 + k * 1024); } while (0)
#define PG8_LDB(dst, b, h) do { _Pragma("unroll") for (int n = 0; n < 2; ++n) _Pragma("unroll") for (int k = 0; k < 2; ++k) dst[n][k] = *(const LAS bf16x8*)(lds + PG8_SB(b, h) + boff + n * 2048 + k * 1024); } while (0)
#define PG8_MMA(ai, bj, At, Bt) do { __builtin_amdgcn_s_setprio(1); _Pragma("unroll") for (int m = 0; m < 4; ++m) _Pragma("unroll") for (int n = 0; n < 2; ++n) _Pragma("unroll") for (int k = 0; k < 2; ++k) \
        acc[ai][bj][m][n] = __builtin_amdgcn_mfma_f32_16x16x32_bf16(Bt[n][k], At[m][k], acc[ai][bj][m][n], 0, 0, 0); __builtin_amdgcn_s_setprio(0); } while (0)
#define PG8_WAIT_V(n) asm volatile("s_waitcnt vmcnt(" #n ")" ::: "memory")
#define PG8_WAIT_L(n) asm volatile("s_waitcnt lgkmcnt(" #n ")" ::: "memory")
#define PG8_BAR __builtin_amdgcn_s_barrier()
#define PG8_SCHED __builtin_amdgcn_sched_barrier(0)
    Unit cur, nxt; int ui = 0;
    if (!S.next(0, cur)) return;
    f32x4 acc[2][2][4][2];
#pragma unroll
    for (int a = 0; a < 2; ++a)
#pragma unroll
        for (int b = 0; b < 2; ++b)
#pragma unroll
            for (int m = 0; m < 4; ++m)
#pragma unroll
                for (int n = 0; n < 2; ++n) acc[a][b][m][n] = (f32x4){0.f, 0.f, 0.f, 0.f};
    bf16x8 At[4][2], B0[2][2], B1[2][2];
    float epre[8] = {0.f, 0.f, 0.f, 0.f, 0.f, 0.f, 0.f, 0.f};
    const char* cA = (const char*)g.A + (size_t)cur.pm * tstep; const char* cB = (const char*)g.Bt + (size_t)cur.pn * tstep;
    PG8_STAGE(PG8_SB(0, 0), cB, voffB); PG8_STAGE(PG8_SB(0, 1), cB + hstep, voffB); PG8_STAGE(PG8_SA(0, 0), cA, voffA); PG8_STAGE(PG8_SA(0, 1), cA + hstep, voffA);
    if (wr == 1) PG8_BAR;
    PG8_WAIT_V(2); PG8_BAR;
    PG8_STAGE(PG8_SB(1, 0), cB + kstep, voffB); PG8_STAGE(PG8_SA(1, 0), cA + kstep, voffA); PG8_STAGE(PG8_SB(1, 1), cB + hstep + kstep, voffB);
    PG8_WAIT_V(6); PG8_BAR;
    for (;;) {
        const bool has_next = S.next(ui + 1, nxt);
        const char* nA = has_next ? (const char*)g.A + (size_t)nxt.pm * tstep : cA; const char* nB = has_next ? (const char*)g.Bt + (size_t)nxt.pn * tstep : cB;
        for (int t = 0; t < nt; t += 2) {
            const bool last = (t == nt - 2);
            if (last) E.pre(cur, wr, fr, epre);
            const char* a1 = cA + (size_t)(t + 1) * kstep;
            const char* a2 = last ? nA : cA + (size_t)(t + 2) * kstep; const char* b2 = last ? nB : cB + (size_t)(t + 2) * kstep;
            const char* a3 = a2 + kstep; const char* b3 = b2 + kstep;
            PG8_LDB(B0, 0, 0); PG8_LDB(B1, 0, 1); PG8_SCHED; PG8_LDA(At, 0, 0); PG8_STAGE(PG8_SA(1, 1), a1 + hstep, voffA);
            PG8_WAIT_V(8); PG8_WAIT_L(0); PG8_BAR; PG8_MMA(0, 0, At, B0); PG8_MMA(0, 1, At, B1); PG8_BAR; PG8_SCHED;
            PG8_LDA(At, 0, 1); PG8_STAGE(PG8_SB(0, 0), b2, voffB); PG8_STAGE(PG8_SB(0, 1), b2 + hstep, voffB); PG8_STAGE(PG8_SA(0, 0), a2, voffA);
            PG8_WAIT_V(8); PG8_WAIT_L(0); PG8_BAR; PG8_MMA(1, 0, At, B0); PG8_MMA(1, 1, At, B1); PG8_BAR; PG8_SCHED;
            PG8_LDB(B0, 1, 0); PG8_LDB(B1, 1, 1); PG8_SCHED; PG8_LDA(At, 1, 0); PG8_STAGE(PG8_SA(0, 1), a2 + hstep, voffA);
            PG8_WAIT_V(8); PG8_WAIT_L(0); PG8_BAR; PG8_MMA(0, 0, At, B0); PG8_MMA(0, 1, At, B1); PG8_BAR; PG8_SCHED;
            PG8_LDA(At, 1, 1); PG8_STAGE(PG8_SB(1, 0), b3, voffB); PG8_STAGE(PG8_SB(1, 1), b3 + hstep, voffB); PG8_STAGE(PG8_SA(1, 0), a3, voffA);
            PG8_WAIT_V(8); PG8_WAIT_L(0); PG8_BAR; PG8_MMA(1, 0, At, B0); PG8_MMA(1, 1, At, B1); PG8_BAR; PG8_SCHED;
        }
        if (wr == 0) PG8_BAR;
        E(acc, cur, wr, wc, fr, fq, epre);
        if (!has_next) break;
#pragma unroll
        for (int a = 0; a < 2; ++a)
#pragma unroll
            for (int b = 0; b < 2; ++b)
#pragma unroll
                for (int m = 0; m < 4; ++m)
#pragma unroll
                    for (int n = 0; n < 2; ++n) acc[a][b][m][n] = (f32x4){0.f, 0.f, 0.f, 0.f};
        cur = nxt; cA = nA; cB = nB; ++ui;
        if (wr == 1) PG8_BAR;
    }
    PG8_WAIT_V(0);
    PG8_BAR;
#undef PG8_SA
#undef PG8_SB
#undef PG8_STAGE
#undef PG8_LDA
#undef PG8_LDB
#undef PG8_MMA
#undef PG8_WAIT_V
#undef PG8_WAIT_L
#undef PG8_BAR
#undef PG8_SCHED
}
}

__device__ __forceinline__ void qkt(f32x16& p0, f32x16& p1, LAS const unsigned char* kslot, const bf16x8 (&qr)[4], int r32, int hi) {
    p0 = (f32x16){}; p1 = (f32x16){};
#pragma unroll
    for (int d0 = 0; d0 < 4; ++d0) {
        LAS const unsigned char* kb = kslot + (2 * d0 + hi) * 1024 + ((r32 ^ (2 * d0 + hi)) * 16); asm volatile("" : "+v"(kb));
        const bf16x8 b0 = *(LAS const bf16x8*)(kb);
        const bf16x8 b1 = *(LAS const bf16x8*)(kb + 512);
        p0 = __builtin_amdgcn_mfma_f32_32x32x16_bf16(b0, qr[d0], p0, 0, 0, 0);
        p1 = __builtin_amdgcn_mfma_f32_32x32x16_bf16(b1, qr[d0], p1, 0, 0, 0);
    }
}
__device__ __forceinline__ s16x4 vtr(LAS const unsigned char* p) { return __builtin_bit_cast(s16x4, __builtin_amdgcn_ds_read_tr16_b64_v4i16((LAS s16x4*)p)); }
__device__ __forceinline__ void pv(f32x16 (&o)[2], LAS const unsigned char* vp, const bf16x8 (&pa)[4]) {
    asm volatile("" : "+v"(vp));
#pragma unroll
    for (int d0 = 0; d0 < 2; ++d0)
#pragma unroll
        for (int ks = 0; ks < 4; ++ks) {
            const s16x4 lo = vtr(vp + d0 * 4096 + ks * 1024), hh = vtr(vp + d0 * 4096 + ks * 1024 + 512);
            const bf16x8 vf = (bf16x8){lo[0], lo[1], lo[2], lo[3], hh[0], hh[1], hh[2], hh[3]};
            o[d0] = __builtin_amdgcn_mfma_f32_32x32x16_bf16(pa[ks], vf, o[d0], 0, 0, 0);
        }
}
struct ModNone { __device__ __forceinline__ void apply(f32x16&, f32x16&, int, int) const {} };
struct ModNA {
    int kcs; LAS const float* tl;
    __device__ __forceinline__ void apply(f32x16& p0, f32x16& p1, int, int) const {
#pragma unroll
        for (int r = 0; r < 16; ++r) { constexpr int dummy = 0; (void)dummy; const int cr = (r & 3) + 8 * (r >> 2);
            { const float v = p0[r] + tl[cr]; p0[r] = ((unsigned)(cr + kcs) < 16u) ? v : -INFINITY; }
            { const float v = p1[r] + tl[cr + 32]; p1[r] = ((unsigned)(cr + 32 + kcs) < 16u) ? v : -INFINITY; } }
    }
};
struct ModDil {
    float af, strf, limf, slope2, tqf, tqmS; bool inb;
    __device__ __forceinline__ void apply(f32x16& p0, f32x16& p1, int, int) const {
        if (inb) {
#pragma unroll
            for (int r = 0; r < 16; ++r) { const float cr = (float)((r & 3) + 8 * (r >> 2));
                { const float d = __builtin_fmaf(-cr, strf, af); const float v = __builtin_fmaf(-slope2, __builtin_fabsf(d), p0[r]); p0[r] = (__builtin_fabsf(d) <= limf) ? v : -INFINITY; }
                { const float d = __builtin_fmaf(-(cr + 32.f), strf, af); const float v = __builtin_fmaf(-slope2, __builtin_fabsf(d), p1[r]); p1[r] = (__builtin_fabsf(d) <= limf) ? v : -INFINITY; } }
        } else {
#pragma unroll
            for (int r = 0; r < 16; ++r) { const float cr = (float)((r & 3) + 8 * (r >> 2));
                { const float d = __builtin_fmaf(-cr, strf, af); const float v = __builtin_fmaf(-slope2, __builtin_fabsf(d), p0[r]); p0[r] = ((__builtin_fabsf(d) <= limf) && (d <= tqf) && (d > tqmS)) ? v : -INFINITY; }
                { const float d = __builtin_fmaf(-(cr + 32.f), strf, af); const float v = __builtin_fmaf(-slope2, __builtin_fabsf(d), p1[r]); p1[r] = ((__builtin_fabsf(d) <= limf) && (d <= tqf) && (d > tqmS)) ? v : -INFINITY; } }
        }
    }
};
template <class Mod>
__device__ __forceinline__ void flash_step(LAS const unsigned char* kslot, LAS const unsigned char* vslot, const bf16x8 (&qr)[4], f32x16 (&o)[2], float& m, float& l, LAS float* wsf, int lane, const Mod& mod) {
    const int r32 = lane & 31, hi = lane >> 5;
    f32x16 p0, p1; qkt(p0, p1, kslot, qr, r32, hi);
    mod.apply(p0, p1, r32, hi);
    float rm = fmaxf(p0[0], p1[0]);
#pragma unroll
    for (int r = 1; r < 16; ++r) rm = fmaxf(rm, fmaxf(p0[r], p1[r]));
    rm = fmaxf(rm, __shfl_xor(rm, 32));
    const float mn = fmaxf(m, rm); const float alpha = __builtin_amdgcn_exp2f(m - mn); m = mn;
    float s = 0.f;
#pragma unroll
    for (int r = 0; r < 16; ++r) { p0[r] = __builtin_amdgcn_exp2f(p0[r] - mn); p1[r] = __builtin_amdgcn_exp2f(p1[r] - mn); s += p0[r] + p1[r]; }
    l = l * alpha + s;
    { LAS float* ww = wsf + r32; asm volatile("" : "+v"(ww)); if (hi == 0) *ww = alpha; }
    asm volatile("" ::: "memory");
    LAS const float* wr_ = wsf + 4 * hi; asm volatile("" : "+v"(wr_));
#pragma unroll
    for (int k = 0; k < 4; ++k) { const f32x4 a = *(LAS const f32x4*)(wr_ + 8 * k);
#pragma unroll
        for (int j = 0; j < 4; ++j) { o[0][4 * k + j] *= a[j]; o[1][4 * k + j] *= a[j]; } }
    bf16x8 pa[4];
    { u32x4 w;
      w = (u32x4){cvtpk(p0[0], p0[1]), cvtpk(p0[2], p0[3]), cvtpk(p0[4], p0[5]), cvtpk(p0[6], p0[7])}; pa[0] = __builtin_bit_cast(bf16x8, w);
      w = (u32x4){cvtpk(p0[8], p0[9]), cvtpk(p0[10], p0[11]), cvtpk(p0[12], p0[13]), cvtpk(p0[14], p0[15])}; pa[1] = __builtin_bit_cast(bf16x8, w);
      w = (u32x4){cvtpk(p1[0], p1[1]), cvtpk(p1[2], p1[3]), cvtpk(p1[4], p1[5]), cvtpk(p1[6], p1[7])}; pa[2] = __builtin_bit_cast(bf16x8, w);
      w = (u32x4){cvtpk(p1[8], p1[9]), cvtpk(p1[10], p1[11]), cvtpk(p1[12], p1[13]), cvtpk(p1[14], p1[15])}; pa[3] = __builtin_bit_cast(bf16x8, w); }
    const int vb = ((lane >> 4) & 1) * 32 + (lane & 3) * 8 + (4 * hi + ((lane & 15) >> 2)) * 64;
    pv(o, vslot + vb, pa);
}
template <class Mod>
__device__ __forceinline__ void flash_scores(LAS const unsigned char* kslot, const bf16x8 (&qr)[4], f32x16 (&o)[2], float& m, float& l, LAS float* wsf, int lane, const Mod& mod, bf16x8 (&pa)[4]) {
    const int r32 = lane & 31, hi = lane >> 5;
    f32x16 p0, p1; qkt(p0, p1, kslot, qr, r32, hi);
    mod.apply(p0, p1, r32, hi);
    float rm = fmaxf(p0[0], p1[0]);
#pragma unroll
    for (int r = 1; r < 16; ++r) rm = fmaxf(rm, fmaxf(p0[r], p1[r]));
    rm = fmaxf(rm, __shfl_xor(rm, 32));
    const float mn = fmaxf(m, rm); const float alpha = __builtin_amdgcn_exp2f(m - mn); m = mn;
    float s = 0.f;
#pragma unroll
    for (int r = 0; r < 16; ++r) { p0[r] = __builtin_amdgcn_exp2f(p0[r] - mn); p1[r] = __builtin_amdgcn_exp2f(p1[r] - mn); s += p0[r] + p1[r]; }
    l = l * alpha + s;
    { LAS float* ww = wsf + r32; asm volatile("" : "+v"(ww)); if (hi == 0) *ww = alpha; }
    asm volatile("" ::: "memory");
    LAS const float* wr_ = wsf + 4 * hi; asm volatile("" : "+v"(wr_));
#pragma unroll
    for (int k = 0; k < 4; ++k) { const f32x4 a = *(LAS const f32x4*)(wr_ + 8 * k);
#pragma unroll
        for (int j = 0; j < 4; ++j) { o[0][4 * k + j] *= a[j]; o[1][4 * k + j] *= a[j]; } }
    { u32x4 w;
      w = (u32x4){cvtpk(p0[0], p0[1]), cvtpk(p0[2], p0[3]), cvtpk(p0[4], p0[5]), cvtpk(p0[6], p0[7])}; pa[0] = __builtin_bit_cast(bf16x8, w);
      w = (u32x4){cvtpk(p0[8], p0[9]), cvtpk(p0[10], p0[11]), cvtpk(p0[12], p0[13]), cvtpk(p0[14], p0[15])}; pa[1] = __builtin_bit_cast(bf16x8, w);
      w = (u32x4){cvtpk(p1[0], p1[1]), cvtpk(p1[2], p1[3]), cvtpk(p1[4], p1[5]), cvtpk(p1[6], p1[7])}; pa[2] = __builtin_bit_cast(bf16x8, w);
      w = (u32x4){cvtpk(p1[8], p1[9]), cvtpk(p1[10], p1[11]), cvtpk(p1[12], p1[13]), cvtpk(p1[14], p1[15])}; pa[3] = __builtin_bit_cast(bf16x8, w); }
    asm volatile("" : "+v"(pa[0]), "+v"(pa[1]), "+v"(pa[2]), "+v"(pa[3]) :: "memory");
}
__device__ __forceinline__ void pv_lane(f32x16 (&o)[2], LAS const unsigned char* vslot, const bf16x8 (&pa)[4], int lane) {
    const int hi = lane >> 5;
    const int vb = ((lane >> 4) & 1) * 32 + (lane & 3) * 8 + (4 * hi + ((lane & 15) >> 2)) * 64;
    pv(o, vslot + vb, pa);
}
__device__ __forceinline__ float max3f(float a, float b, float c) { float r; asm("v_max3_f32 %0, %1, %2, %3" : "=v"(r) : "v"(a), "v"(b), "v"(c)); return r; }
__device__ __forceinline__ float rowmax32(const f32x16& p0, const f32x16& p1) {
    float a = max3f(p0[0], p0[1], p1[0]), b = max3f(p0[2], p0[3], p1[1]); a = max3f(a, p1[2], p1[3]);
#pragma unroll
    for (int r = 4; r < 16; r += 4) { a = max3f(a, p0[r], p0[r + 1]); b = max3f(b, p0[r + 2], p0[r + 3]); a = max3f(a, p1[r], p1[r + 1]); b = max3f(b, p1[r + 2], p1[r + 3]); }
    return fmaxf(a, b);
}
constexpr float THRL = 8.f;
__device__ __forceinline__ void qkt2(f32x16& p0, f32x16& p1, LAS const unsigned char* kslot, const bf16x8 (&qr)[4], const f32x16& negm, int r32, int hi) {
#pragma unroll
    for (int d0 = 0; d0 < 4; ++d0) {
        LAS const unsigned char* kb = kslot + (2 * d0 + hi) * 1024 + ((r32 ^ (2 * d0 + hi)) * 16); asm volatile("" : "+v"(kb));
        const bf16x8 b0 = *(LAS const bf16x8*)(kb);
        const bf16x8 b1 = *(LAS const bf16x8*)(kb + 512);
        if (d0 == 0) { p0 = __builtin_amdgcn_mfma_f32_32x32x16_bf16(b0, qr[0], negm, 0, 0, 0); p1 = __builtin_amdgcn_mfma_f32_32x32x16_bf16(b1, qr[0], negm, 0, 0, 0); }
        else { p0 = __builtin_amdgcn_mfma_f32_32x32x16_bf16(b0, qr[d0], p0, 0, 0, 0); p1 = __builtin_amdgcn_mfma_f32_32x32x16_bf16(b1, qr[d0], p1, 0, 0, 0); }
    }
}
template <bool HASNEXT, class Mod>
__device__ __forceinline__ void softmax2(f32x16& p0, f32x16& p1, f32x16 (&o)[2], f32x16& negm, float& mref, float& l, LAS float* wsf, int lane, const Mod& mod, bf16x8 (&pa)[4], f32x16& n0, f32x16& n1) {
    const int r32 = lane & 31, hi = lane >> 5;
    mod.apply(p0, p1, r32, hi);
    float rm = rowmax32(p0, p1);
    if (__builtin_expect(__any(rm > THRL), 0)) {
        rm = fmaxf(rm, __shfl_xor(rm, 32));
        const float dl = fmaxf(rm, 0.f);
        mref += dl;
#pragma unroll
        for (int r = 0; r < 16; ++r) { p0[r] -= dl; p1[r] -= dl; }
        if (HASNEXT) {
#pragma unroll
            for (int r = 0; r < 16; ++r) { n0[r] -= dl; n1[r] -= dl; } }
#pragma unroll
        for (int r = 0; r < 16; ++r) negm[r] = -mref;
        const float f = __builtin_amdgcn_exp2f(-dl); l *= f;
        { LAS float* ww = wsf + r32; asm volatile("" : "+v"(ww)); if (hi == 0) *ww = f; }
        asm volatile("" ::: "memory");
        LAS const float* wr_ = wsf + 4 * hi; asm volatile("" : "+v"(wr_));
#pragma unroll
        for (int k = 0; k < 4; ++k) { const f32x4 a = *(LAS const f32x4*)(wr_ + 8 * k);
#pragma unroll
            for (int j = 0; j < 4; ++j) { o[0][4 * k + j] *= a[j]; o[1][4 * k + j] *= a[j]; } }
    }
    float s = 0.f;
#pragma unroll
    for (int r = 0; r < 16; ++r) { p0[r] = __builtin_amdgcn_exp2f(p0[r]); p1[r] = __builtin_amdgcn_exp2f(p1[r]); s += p0[r] + p1[r]; }
    l += s;
    { u32x4 w;
      w = (u32x4){cvtpk(p0[0], p0[1]), cvtpk(p0[2], p0[3]), cvtpk(p0[4], p0[5]), cvtpk(p0[6], p0[7])}; pa[0] = __builtin_bit_cast(bf16x8, w);
      w = (u32x4){cvtpk(p0[8], p0[9]), cvtpk(p0[10], p0[11]), cvtpk(p0[12], p0[13]), cvtpk(p0[14], p0[15])}; pa[1] = __builtin_bit_cast(bf16x8, w);
      w = (u32x4){cvtpk(p1[0], p1[1]), cvtpk(p1[2], p1[3]), cvtpk(p1[4], p1[5]), cvtpk(p1[6], p1[7])}; pa[2] = __builtin_bit_cast(bf16x8, w);
      w = (u32x4){cvtpk(p1[8], p1[9]), cvtpk(p1[10], p1[11]), cvtpk(p1[12], p1[13]), cvtpk(p1[14], p1[15])}; pa[3] = __builtin_bit_cast(bf16x8, w); }
}
__device__ __forceinline__ void flash_finish(f32x16 (&o)[2], float l, LAS float* wsf, LAS unsigned char* stg, bf16_t* Obase, size_t qstride, int lane) {
    asm volatile("" : "+v"(lane));
    const int r32 = lane & 31, hi = lane >> 5;
    l += __shfl_xor(l, 32);
    { LAS float* ww = wsf + 32 + r32; asm volatile("" : "+v"(ww)); if (hi == 0) *ww = l; }
    asm volatile("" ::: "memory");
    LAS const float* wr_ = wsf + 32 + 4 * hi; asm volatile("" : "+v"(wr_));
    LAS bf16_t* st = (LAS bf16_t*)stg + (4 * hi) * 64 + r32; asm volatile("" : "+v"(st));
#pragma unroll
    for (int k = 0; k < 4; ++k) { const f32x4 a = *(LAS const f32x4*)(wr_ + 8 * k);
#pragma unroll
        for (int j = 0; j < 4; ++j) { const float rl = __builtin_amdgcn_rcpf(a[j]);
            st[(j + 8 * k) * 64] = (bf16_t)(cvtpk(o[0][4 * k + j] * rl, 0.f) & 0xffffu);
            st[(j + 8 * k) * 64 + 32] = (bf16_t)(cvtpk(o[1][4 * k + j] * rl, 0.f) & 0xffffu); } }
    asm volatile("" ::: "memory");
    LAS const bf16_t* sr = (LAS const bf16_t*)stg + (lane >> 3) * 64 + (lane & 7) * 8; asm volatile("" : "+v"(sr));
    bf16_t* op = Obase + (size_t)(lane >> 3) * qstride + (lane & 7) * 8;
#pragma unroll
    for (int i = 0; i < 4; ++i) { const u32x4 v = *(LAS const u32x4*)(sr + i * 8 * 64);
        *(u32x4*)(op + (size_t)(i * 8) * qstride) = v; }
}

__device__ __forceinline__ void flash_finish_c(f32x16 (&o)[2], float l, float mref, LAS float* wsf, LAS unsigned char* stg, bf16_t* Obase, size_t qstride, int lane, float* lse0, int lstep, bool merge) {
    asm volatile("" : "+v"(lane));
    const int r32 = lane & 31, hi = lane >> 5;
    float* lsep = lse0 + (size_t)r32 * lstep;
    l += __shfl_xor(l, 32);
    const float lse2 = mref + __builtin_amdgcn_logf(l);
    float fa = 0.f, rl = __builtin_amdgcn_rcpf(l);
    if (merge) { const float lse1 = *lsep; const float M = fmaxf(lse1, lse2); const float w1 = __builtin_amdgcn_exp2f(lse1 - M), w2 = __builtin_amdgcn_exp2f(lse2 - M); const float inv = __builtin_amdgcn_rcpf(w1 + w2); fa = w1 * inv; rl = w2 * inv * rl; }
    else if (hi == 0) *lsep = lse2;
    { LAS float* ww = wsf + r32; asm volatile("" : "+v"(ww)); if (hi == 0) { ww[0] = fa; ww[32] = rl; } }
    asm volatile("" ::: "memory");
    LAS const float* wr_ = wsf + 32 + 4 * hi; asm volatile("" : "+v"(wr_));
    LAS bf16_t* st = (LAS bf16_t*)stg + (4 * hi) * 64 + r32; asm volatile("" : "+v"(st));
#pragma unroll
    for (int k = 0; k < 4; ++k) { const f32x4 a = *(LAS const f32x4*)(wr_ + 8 * k);
#pragma unroll
        for (int j = 0; j < 4; ++j) {
            st[(j + 8 * k) * 64] = (bf16_t)(cvtpk(o[0][4 * k + j] * a[j], 0.f) & 0xffffu);
            st[(j + 8 * k) * 64 + 32] = (bf16_t)(cvtpk(o[1][4 * k + j] * a[j], 0.f) & 0xffffu); } }
    asm volatile("" ::: "memory");
    LAS const bf16_t* sr = (LAS const bf16_t*)stg + (lane >> 3) * 64 + (lane & 7) * 8; asm volatile("" : "+v"(sr));
    LAS const float* fr_ = wsf + (lane >> 3); asm volatile("" : "+v"(fr_));
    bf16_t* op = Obase + (size_t)(lane >> 3) * qstride + (lane & 7) * 8;
#pragma unroll
    for (int i = 0; i < 4; ++i) { u32x4 v = *(LAS const u32x4*)(sr + i * 8 * 64);
        if (merge) { const float f = fr_[i * 8]; const u32x4 g = *(const u32x4*)(op + (size_t)(i * 8) * qstride);
            v.x = cvtpk(__builtin_fmaf(f, __builtin_bit_cast(float, g.x << 16), __builtin_bit_cast(float, v.x << 16)), __builtin_fmaf(f, __builtin_bit_cast(float, g.x & 0xffff0000u), __builtin_bit_cast(float, v.x & 0xffff0000u)));
            v.y = cvtpk(__builtin_fmaf(f, __builtin_bit_cast(float, g.y << 16), __builtin_bit_cast(float, v.y << 16)), __builtin_fmaf(f, __builtin_bit_cast(float, g.y & 0xffff0000u), __builtin_bit_cast(float, v.y & 0xffff0000u)));
            v.z = cvtpk(__builtin_fmaf(f, __builtin_bit_cast(float, g.z << 16), __builtin_bit_cast(float, v.z << 16)), __builtin_fmaf(f, __builtin_bit_cast(float, g.z & 0xffff0000u), __builtin_bit_cast(float, v.z & 0xffff0000u)));
            v.w = cvtpk(__builtin_fmaf(f, __builtin_bit_cast(float, g.w << 16), __builtin_bit_cast(float, v.w << 16)), __builtin_fmaf(f, __builtin_bit_cast(float, g.w & 0xffff0000u), __builtin_bit_cast(float, v.w & 0xffff0000u))); }
        *(u32x4*)(op + (size_t)(i * 8) * qstride) = v; }
}

#define XB_TMO      128
#define XB_XCNT(j)  (256  + 64 * (j))
#define XB_XSUB(j)  (1280 + 64 * (j))
#define XB_XGEN(j)  (2304 + 64 * (j))
#define XB_TOP      3328
#define XB_TOPGEN   3392
#define XCD_BAR_WORDS 3456
#define XB_SPIN_CAP (1u << 22)
__device__ __forceinline__ unsigned xb_ld(unsigned* p)              { return __hip_atomic_load(p, __ATOMIC_RELAXED, __HIP_MEMORY_SCOPE_AGENT); }
__device__ __forceinline__ unsigned xb_add(unsigned* p, unsigned v) { return __hip_atomic_fetch_add(p, v, __ATOMIC_RELAXED, __HIP_MEMORY_SCOPE_AGENT); }
__device__ __forceinline__ unsigned xb_xcc_id() { return (unsigned)__builtin_amdgcn_s_getreg((3 << 11) | 20) & 0xFu; }
#define XB_SPIN(cond, bar) do { unsigned _sp = 0; while (cond) { __builtin_amdgcn_s_sleep(1); \
    if ((++_sp & 255u) == 0u) { if (xb_ld(&(bar)[XB_TMO])) break; if (_sp > XB_SPIN_CAP) { atomicAdd(&(bar)[XB_TMO], 1u); break; } } } } while (0)
struct XcdBarrier { unsigned* bar; unsigned x; volatile LAS unsigned* st; };
__device__ __forceinline__ XcdBarrier xcd_barrier_post(unsigned* bar, volatile LAS unsigned* st) {
    XcdBarrier b; b.bar = bar; b.x = xb_xcc_id(); b.st = st;
    if (threadIdx.x == 0) (void)xb_add(&bar[XB_XCNT(b.x)], 1u);
    return b;
}
__device__ __forceinline__ void xcd_barrier_complete(unsigned* bar, unsigned x, unsigned& nloc, unsigned& nx) {
    const unsigned G = gridDim.x * gridDim.y * gridDim.z;
    unsigned sum, cnt, mine, sp = 0u;
    for (;;) {
        sum = 0u; cnt = 0u; mine = 0u;
#pragma unroll
        for (unsigned j = 0; j < 16; ++j) { const unsigned c = xb_ld(&bar[XB_XCNT(j)]); sum += c; cnt += (c > 0u) ? 1u : 0u; mine = (j == x) ? c : mine; }
        if (sum == G) break;
        __builtin_amdgcn_s_sleep(1);
        if ((++sp & 255u) == 0u) { if (xb_ld(&bar[XB_TMO])) break; if (sp > XB_SPIN_CAP) { atomicAdd(&bar[XB_TMO], 1u); break; } }
    }
    nloc = mine > 0u ? mine : 1u; nx = cnt > 0u ? cnt : 1u;
}
__device__ __forceinline__ void xcd_barrier(const XcdBarrier& b) {
    asm volatile("s_waitcnt vmcnt(0)" ::: "memory");
    __syncthreads();
    if (threadIdx.x == 0) {
        unsigned* bar = b.bar;
        __builtin_amdgcn_s_waitcnt(0);
        unsigned nloc = b.st[0], nx = b.st[1];
        if (nloc == 0u) { xcd_barrier_complete(bar, b.x, nloc, nx); b.st[0] = nloc; b.st[1] = nx; }
        const unsigned old = xb_add(&bar[XB_XSUB(b.x)], 1u);
        const unsigned gen = old / nloc;
        if (old + 1u == (gen + 1u) * nloc) {
            __builtin_amdgcn_fence(__ATOMIC_RELEASE, "agent");
            asm volatile("s_waitcnt vmcnt(0)" ::: "memory");
            const unsigned og = xb_add(&bar[XB_TOP], 1u);
            const unsigned tg = og / nx;
            if (og + 1u == (tg + 1u) * nx) xb_add(&bar[XB_TOPGEN], 1u);
            else XB_SPIN(xb_ld(&bar[XB_TOPGEN]) == tg, bar);
            __builtin_amdgcn_fence(__ATOMIC_ACQUIRE, "agent");
            xb_add(&bar[XB_XGEN(b.x)], 1u);
            asm volatile("s_waitcnt vmcnt(0)" ::: "memory");
        } else {
            XB_SPIN(xb_ld(&bar[XB_XGEN(b.x)]) == gen, bar);
            __builtin_amdgcn_fence(__ATOMIC_ACQUIRE, "agent");
            asm volatile("s_waitcnt vmcnt(0)" ::: "memory");
        }
    }
    __syncthreads();
}

struct Params { const float* in[14]; float* out; unsigned char* ws; };

__device__ __forceinline__ void transpose_item(const float* W, int K, int N, bf16_t* WT, const float* gain, int mode, LAS float* scr, int item, int lane) {
    const int nblk = N / 32, kb = item / nblk, nb = item % nblk, k0 = 64 * kb, n0 = 32 * nb;
#pragma unroll 8
    for (int i = 0; i < 32; ++i) { const int kk = 2 * i + (lane >> 5); float w = W[(size_t)(k0 + kk) * N + n0 + (lane & 31)]; if (gain) w *= gain[k0 + kk]; scr[kk * 33 + (lane & 31)] = w; }
    int d0 = n0;
    if (mode == 1) { const int j = n0 < DFF ? n0 : n0 - DFF; d0 = 256 * (j >> 7) + (j & 127) + (n0 < DFF ? 0 : 128); }
    const int c = lane & 7;
#pragma unroll
    for (int j = 0; j < 4; ++j) { const int n = (lane >> 3) + 8 * j; const LAS float* s = scr + (8 * c) * 33 + n;
        u32x4 o; o.x = cvtpk(s[0 * 33], s[1 * 33]); o.y = cvtpk(s[2 * 33], s[3 * 33]); o.z = cvtpk(s[4 * 33], s[5 * 33]); o.w = cvtpk(s[6 * 33], s[7 * 33]);
        *(u32x4*)(WT + (size_t)(d0 + n) * K + k0 + 8 * c) = o; }
}

__global__ void __launch_bounds__(NTHREADS) fwd_megakernel(Params P) {
#define GAS __attribute__((address_space(1)))
#define KA(i) ((const float*)(const GAS float*)ka[(i)])
    extern __shared__ __attribute__((aligned(16))) unsigned char lds_raw[];
    cg::grid_group grid = cg::this_grid();
    LAS unsigned char* lds = (LAS unsigned char*)lds_raw;
    const int tid0 = threadIdx.x, wave = __builtin_amdgcn_readfirstlane(tid0 >> 6);
    const int G = gridDim.x, bx = blockIdx.x;
    const int vcu = (G % 8 == 0) ? (bx % 8) * (G / 8) + bx / 8 : bx;
    const int gw = vcu * NWAVES + wave, NGW = G * NWAVES;
    LAS float* wsf = (LAS float*)(lds + WSF_OFF) + wave * 64;
    volatile LAS unsigned* bst = (volatile LAS unsigned*)(lds + PTAB_OFF);
    if (tid0 < 2) bst[tid0] = 0u;
    __syncthreads();
    XcdBarrier xbar = xcd_barrier_post((unsigned*)(P.ws + WS_BAR), bst);

    for (int ph = 0; ph <= 24; ++ph) {
        const __attribute__((address_space(4))) unsigned long long* ka = (const __attribute__((address_space(4))) unsigned long long*)__builtin_amdgcn_kernarg_segment_ptr(); asm volatile("" : "+s"(ka));
        unsigned char* ws = (unsigned char*)(GAS unsigned char*)ka[15];
        f32x2* rope = (f32x2*)(ws + WS_ROPE);
        float* ssq_all = (float*)(ws + WS_SSQ);
        bf16_t* QKV = (bf16_t*)(ws + WS_QKV); bf16_t* HB = (bf16_t*)(ws + WS_H); bf16_t* OB = (bf16_t*)(ws + WS_O);
        int tid = tid0; asm volatile("" : "+v"(tid));
        const int lane = tid & 63, r32 = lane & 31, hi = lane >> 5;
        const int c = ph / 12, s = ph % 12;
        const int S = (c == 0) ? 8192 : 4096, nb = RC / S;
        const float* xin = KA(c & 1);
        float* xout = ((float*)(GAS float*)ka[14]) + (size_t)(c & 1) * RC * DM;
        float* ssq = ssq_all + (size_t)(c & 1) * 5 * RC;
        bf16_t* XB = (bf16_t*)(ws + ((c & 1) ? WS_XB1 : WS_XB));
        if (s == 0) {
            if (ph == 0 && (PHM & 1)) {
                LAS float* scr = (LAS float*)(lds + wave * 16384);
                constexpr int I0 = 16 * (NE / 32), I1 = 16 * (DM / 32), I2 = 16 * (NO / 32), I3 = I1, I4 = 16 * (NGU / 32), I5 = I4, I6 = (DFF / 64) * (DM / 32), I7 = I6;
                constexpr int NIT = I0 + I1 + I2 + I3 + I4 + I5 + I6 + I7;
                for (int it = gw; it < NIT; it += NGW) {
                    int r = it;
                    if (r < I0) { transpose_item(KA(5), DM, NE, (bf16_t*)(ws + W_INE), KA(2), 0, scr, r, lane); continue; } r -= I0;
                    if (r < I1) { transpose_item(KA(9), DM, DM, (bf16_t*)(ws + W_OUTE), nullptr, 0, scr, r, lane); continue; } r -= I1;
                    if (r < I2) { transpose_item(KA(10), DM, NO, (bf16_t*)(ws + W_INO), KA(2) + DM, 0, scr, r, lane); continue; } r -= I2;
                    if (r < I3) { transpose_item(KA(11), DM, DM, (bf16_t*)(ws + W_OUTO), nullptr, 0, scr, r, lane); continue; } r -= I3;
                    if (r < I4) { transpose_item(KA(12), DM, NGU, (bf16_t*)(ws + W_GU0), KA(3), 1, scr, r, lane); continue; } r -= I4;
                    if (r < I5) { transpose_item(KA(12) + (size_t)DM * NGU, DM, NGU, (bf16_t*)(ws + W_GU1), KA(3) + DM, 1, scr, r, lane); continue; } r -= I5;
                    if (r < I6) { transpose_item(KA(13), DFF, DM, (bf16_t*)(ws + W_DN0), nullptr, 0, scr, r, lane); continue; } r -= I6;
                    transpose_item(KA(13) + (size_t)DFF * DM, DFF, DM, (bf16_t*)(ws + W_DN1), nullptr, 0, scr, r, lane);
                }
                const int gt = vcu * NTHREADS + tid;
                if (gt < 2048) { const int pos = gt >> 4, i = gt & 15; const float fr = __builtin_amdgcn_exp2f(-(float)i * (13.287712379549449f / 16.f)); const float ang = (float)pos * fr;
                    float sn, cs; sincosf(ang, &sn, &cs); rope[gt] = (f32x2){cs, sn}; }
            }
            if (c >= 1) {
                float* po = ((float*)(GAS float*)ka[14]) + (size_t)(c - 1) * RC * DM; const float* pq = ssq_all + (size_t)(c - 1) * 5 * RC + 4 * RC; const float* gf = KA(4);
                const bf16_t* xp = (const bf16_t*)(ws + (((c - 1) & 1) ? WS_XB1 : WS_XB));
                for (int row = gw; row < RC; row += NGW) { const float rs = __builtin_amdgcn_rsqf(pq[row] * (1.f / DM) + EPS);
#pragma unroll
                    for (int hf = 0; hf < 2; ++hf) { const u32x4 r = __builtin_nontemporal_load((const u32x4*)(xp + (size_t)row * DM + hf * 512 + lane * 8));
                        const f32x4 g0 = *(const f32x4*)(gf + hf * 512 + lane * 8), g1 = *(const f32x4*)(gf + hf * 512 + lane * 8 + 4);
                        f32x4 y0, y1;
                        y0[0] = __builtin_bit_cast(float, r.x << 16); y0[1] = __builtin_bit_cast(float, r.x & 0xffff0000u); y0[2] = __builtin_bit_cast(float, r.y << 16); y0[3] = __builtin_bit_cast(float, r.y & 0xffff0000u);
                        y1[0] = __builtin_bit_cast(float, r.z << 16); y1[1] = __builtin_bit_cast(float, r.z & 0xffff0000u); y1[2] = __builtin_bit_cast(float, r.w << 16); y1[3] = __builtin_bit_cast(float, r.w & 0xffff0000u);
                        f32x4* op = (f32x4*)(po + (size_t)row * DM + hf * 512 + lane * 8);
                        __builtin_nontemporal_store(y0 * rs * g0, op); __builtin_nontemporal_store(y1 * rs * g1, op + 1); } }
            }
            if (c < 2) {
                for (int row = gw; row < RC; row += NGW) { const f32x4* xr = (const f32x4*)(xin + (size_t)row * DM) + lane; f32x4 v[4]; float sq = 0.f;
#pragma unroll
                    for (int j = 0; j < 4; ++j) { v[j] = __builtin_nontemporal_load(xr + 64 * j); sq += (v[j].x * v[j].x + v[j].y * v[j].y) + (v[j].z * v[j].z + v[j].w * v[j].w); }
                    sq = wave_sum(sq); u32x2* o8 = (u32x2*)(XB + (size_t)row * DM) + lane;
#pragma unroll
                    for (int j = 0; j < 4; ++j) o8[64 * j] = (u32x2){cvtpk(v[j].x, v[j].y), cvtpk(v[j].z, v[j].w)};
                    if (lane < 5) ssq[(size_t)lane * RC + row] = lane == 0 ? sq : 0.f; }
            }
        } else if ((s == 1 || s == 7) && (PHM & 2)) {
            const int N = (s == 1) ? NE : NO;
            pg8::Gemm g{XB, (const bf16_t*)(ws + (s == 1 ? W_INE : W_INO)), RC, N, DM}; pg8::StaticOrder SO; SO.init(RC, N, G, bx);
            pg8::EpiScaleBf16 E{QKV, (s == 1) ? NEP : NOP, ssq + (s == 1 ? 0 : 2) * (size_t)RC, (s == 1) ? 3 : 0, (s == 1) ? 5 : 4, C2};
            for (int rep = 0; rep < ((DUP & 4) ? 2 : 1); ++rep) pg8::gemm_phase<pg8::EpiScaleBf16>(lds, g, SO, E, wave);
        } else if ((s == 4 || s == 6 || s == 9 || s == 11) && (PHM & 4)) {
            const bool dn = (s == 6 || s == 11); const int K = dn ? DFF : DM;
            const size_t woff = (s == 4) ? W_OUTE : (s == 6) ? W_DN0 : (s == 9) ? W_OUTO : W_DN1;
            pg8::Gemm g{dn ? HB : OB, (const bf16_t*)(ws + woff), RC, DM, K}; pg8::StaticOrder SO; SO.init(RC, DM, G, bx);
            const int qi = (s == 4) ? 1 : (s == 6) ? 2 : (s == 9) ? 3 : 4;
            pg8::EpiResidual E{XB, ssq + (size_t)qi * RC};
            pg8::gemm_phase<pg8::EpiResidual>(lds, g, SO, E, wave);
        } else if ((s == 5 || s == 10) && (PHM & 8)) {
            pg8::Gemm g{XB, (const bf16_t*)(ws + (s == 5 ? W_GU0 : W_GU1)), RC, NGU, DM}; pg8::StaticOrder SO; SO.init(RC, NGU, G, bx);
            pg8::EpiSwiGLU E{HB, ssq + (size_t)(s == 5 ? 1 : 3) * RC};
            for (int rep = 0; rep < ((DUP & 4) ? 2 : 1); ++rep) pg8::gemm_phase<pg8::EpiSwiGLU>(lds, g, SO, E, wave);
        } else if (s == 2 && (PHM & 16)) {
            const float* gq = KA(6); const float* gk = KA(7);
            for (int row = gw; row < RC; row += NGW) { const int t = row & (S - 1), pr = t >> 6, pc = t & 63;
#pragma unroll
                for (int pass = 0; pass < 2; ++pass) { const int hh0 = (lane >> 3) + 8 * pass; const bool act = hh0 < 10; const int hh = act ? hh0 : 9; const int cc = lane & 7;
                    bf16_t* ptr = QKV + (size_t)row * NEP + hh * 64 + cc * 8; const u32x4 raw = *(const u32x4*)ptr; const float* gn = (hh < 8 ? gq : gk) + cc * 8;
                    float y[8]; y[0] = bf2f(raw.x & 0xffff); y[1] = bf2f(raw.x >> 16); y[2] = bf2f(raw.y & 0xffff); y[3] = bf2f(raw.y >> 16); y[4] = bf2f(raw.z & 0xffff); y[5] = bf2f(raw.z >> 16); y[6] = bf2f(raw.w & 0xffff); y[7] = bf2f(raw.w >> 16);
                    float sq = 0.f;
#pragma unroll
                    for (int j = 0; j < 8; ++j) sq += y[j] * y[j];
                    sq += __shfl_xor(sq, 1); sq += __shfl_xor(sq, 2); sq += __shfl_xor(sq, 4);
                    const float rn = __builtin_amdgcn_rsqf(sq * (1.f / 64.f) + EPS);
                    const int pos = (cc >> 2) ? pc : pr; const f32x2* tb = rope + pos * 16 + (cc & 1) * 8; const bool first = (cc & 3) < 2; const float sc = hh < 8 ? C2 : 1.f;
                    float ov[8];
#pragma unroll
                    for (int j = 0; j < 8; ++j) { const float yy = y[j] * rn * gn[j]; const float py = __shfl_xor(yy, 2); const f32x2 cs = tb[j];
                        ov[j] = (first ? (yy * cs.x - py * cs.y) : (py * cs.y + yy * cs.x)) * sc; }
                    if (act) *(u32x4*)ptr = (u32x4){cvtpk(ov[0], ov[1]), cvtpk(ov[2], ov[3]), cvtpk(ov[4], ov[5]), cvtpk(ov[6], ov[7])}; } }
            { LAS float* tabL = (LAS float*)(lds + RPB_OFF); const float* rpb = KA(8);
              for (int i = tid; i < 3720; i += NTHREADS) tabL[i] = rpb[i] * LOG2E;
              __syncthreads();
              const int rows = S >> 6; const int ntask = nb * rows * 16;
              LAS unsigned char* wl = lds + wave * 16384;
              for (int rep = 0; rep < ((DUP & 2) ? 2 : 1); ++rep)
              for (int wt = gw; wt < ntask; wt += NGW) {
                  const int qh = wt & 1, h = (wt >> 1) & 7, br = wt >> 4, r = br % rows, b = br / rows;
                  const int rs0 = min(max(r - 4, 0), rows - 8);
                  const size_t rowbase = (size_t)b * S;
                  const int qc = qh * 32 + r32, cs = min(max(qc - 8, 0), 48);
                  const bf16_t* qp = QKV + (rowbase + r * 64 + qc) * NEP + 768 + h * 64 + hi * 8;
                  bf16x8 qr[4];
#pragma unroll
                  for (int d0 = 0; d0 < 4; ++d0) qr[d0] = *(const bf16x8*)(qp + d0 * 16);
                  f32x16 o[2]; o[0] = (f32x16){}; o[1] = (f32x16){}; f32x16 negm = (f32x16){}; float mref = 0.f, l = 0.f;
                  const int lrow = lane >> 3, ch = lane & 7;
                  const int lrowV = 2 * (lane >> 4) + ((lane >> 2) & 1), dhV = (lane >> 3) & 1, cwV = lane & 3;
                  const bf16_t* kp = QKV + (rowbase + (size_t)rs0 * 64 + lrow) * NEP + 1280 + h * 64 + ch * 8;
                  const bf16_t* vp = QKV + (rowbase + (size_t)rs0 * 64 + lrowV) * NEP + 1792 + h * 64 + dhV * 32 + cwV * 8;
                  u32x4 kr[8], vr[8];
#pragma unroll
                  for (int j = 0; j < 8; ++j) { kr[j] = *(const u32x4*)(kp + (size_t)(8 * j) * NEP); vr[j] = *(const u32x4*)(vp + (size_t)(8 * j) * NEP); }
                  const int kcs = 4 * hi - cs;
                  for (int jt = 0; jt < 8; ++jt) {
                      LAS unsigned char* kw = wl + ch * 1024 + (lrow ^ ch) * 16; LAS unsigned char* vw = wl + 8192 + dhV * 4096 + lrowV * 64 + cwV * 16; asm volatile("" : "+v"(kw), "+v"(vw));
#pragma unroll
                      for (int j = 0; j < 8; ++j) { *(LAS u32x4*)(kw + j * 128) = kr[j]; *(LAS u32x4*)(vw + j * 512) = vr[j]; }
                      int kcs_ = kcs; asm volatile("" : "+v"(kcs_));
                      ModNA mod{kcs_, tabL + (h * 15 + (rs0 + jt - r + 7)) * 31 + (15 - qc + 4 * hi)};
                      bf16x8 pa[4];
                      if (jt + 1 < 8) { const bf16_t* kn = kp + (size_t)(jt + 1) * 64 * NEP; const bf16_t* vn = vp + (size_t)(jt + 1) * 64 * NEP;
#pragma unroll
                          for (int j = 0; j < 8; ++j) { kr[j] = *(const u32x4*)(kn + (size_t)(8 * j) * NEP); vr[j] = *(const u32x4*)(vn + (size_t)(8 * j) * NEP); } }
                      f32x16 s0, s1;
                      qkt2(s0, s1, wl, qr, negm, r32, hi);
                      softmax2<false>(s0, s1, o, negm, mref, l, wsf, lane, mod, pa, s0, s1);
                      pv_lane(o, wl + 8192, pa, lane);
                      asm volatile("" ::: "memory");
                  }
                  flash_finish(o, l, wsf, wl, OB + (rowbase + r * 64 + qh * 32) * DM + 512 + h * 64, DM, lane);
              } }
        } else if (s == 3 && (PHM & 32)) {
            const int nqb = S >> 8, ntask = nb * 8 * nqb, NT = S >> 6;
            LAS unsigned char* stg = lds + 81920 + wave * 4096;
            float gqm = 0.f, gkm = 0.f;
            { const float* gq = KA(6); const float* gk = KA(7);
              for (int i = 0; i < 64; ++i) { gqm = fmaxf(gqm, __builtin_fabsf(gq[i])); gkm = fmaxf(gkm, __builtin_fabsf(gk[i])); } }
            const float sbound = 64.f * C2 * gqm * gkm * 1.001f;
            const bool fastA = sbound < 64.f;
            for (int rep = 0; rep < ((DUP & 1) ? 2 : 1); ++rep)
            for (int task = vcu; task < ntask; task += G) {
                const int qb = task % nqb, bh = task / nqb, h = bh & 7, b = bh >> 3;
                const size_t rowbase = (size_t)b * S;
                const int q0 = qb * 256 + wave * 32;
                const bf16_t* qp = QKV + (rowbase + q0 + r32) * NEP + h * 64 + hi * 8;
                bf16x8 qr[4];
#pragma unroll
                for (int d0 = 0; d0 < 4; ++d0) qr[d0] = *(const bf16x8*)(qp + d0 * 16);
                f32x16 o[2]; o[0] = (f32x16){}; o[1] = (f32x16){}; float l = 0.f;
                const int trow = wave * 8 + (lane >> 3), ch = lane & 7;
                const int trowV = wave * 8 + 2 * (lane >> 4) + ((lane >> 2) & 1), dhV = (lane >> 3) & 1, cwV = lane & 3;
                const bf16_t* kp = QKV + (rowbase + trow) * NEP + 512 + (h >> 2) * 64 + ch * 8;
                const bf16_t* vp = QKV + (rowbase + trowV) * NEP + 640 + (h >> 2) * 64 + dhV * 32 + cwV * 8;
                const unsigned kdst = ch * 1024 + (trow ^ ch) * 16, vdst = 8192 + dhV * 4096 + trowV * 64 + cwV * 16;
                u32x4 kreg = *(const u32x4*)kp, vreg = *(const u32x4*)vp;
                if (!fastA) {
                    float m = -1e30f;
                    *(LAS u32x4*)(lds + kdst) = kreg; *(LAS u32x4*)(lds + vdst) = vreg;
                    __syncthreads();
                    for (int t = 0; t < NT; ++t) {
                        const unsigned cur = (t & 1) * 16384u, nxt = 16384u - cur;
                        if (t + 1 < NT) { kreg = *(const u32x4*)(kp + (size_t)(t + 1) * 64 * NEP); vreg = *(const u32x4*)(vp + (size_t)(t + 1) * 64 * NEP); }
                        flash_step(lds + cur, lds + cur + 8192, qr, o, m, l, wsf, lane, ModNone{});
                        if (t + 1 < NT) { *(LAS u32x4*)(lds + nxt + kdst) = kreg; *(LAS u32x4*)(lds + nxt + vdst) = vreg; }
                        __syncthreads();
                    }
                    flash_finish(o, l, wsf, stg, OB + (rowbase + q0) * DM + h * 64, DM, lane);
                    continue;
                }
                u32x4 kreg1 = *(const u32x4*)(kp + (size_t)64 * NEP), vreg1 = *(const u32x4*)(vp + (size_t)64 * NEP);
                u32x4 kreg2 = *(const u32x4*)(kp + (size_t)128 * NEP), vreg2 = *(const u32x4*)(vp + (size_t)128 * NEP);
                *(LAS u32x4*)(lds + kdst) = kreg; *(LAS u32x4*)(lds + vdst) = vreg;
                *(LAS u32x4*)(lds + 16384 + kdst) = kreg1; *(LAS u32x4*)(lds + 16384 + vdst) = vreg1;
                *(LAS u32x4*)(lds + 32768 + kdst) = kreg2; *(LAS u32x4*)(lds + 32768 + vdst) = vreg2;
                __syncthreads();
                f32x16 sa0, sa1, sb0, sb1;
                { const f32x16 z_ = (f32x16){}; qkt2(sa0, sa1, lds, qr, z_, r32, hi); }
                unsigned bcur = 0, bnxt = 16384, bnn = 49152;
                const int vbl = ((lane >> 4) & 1) * 32 + (lane & 3) * 8 + (4 * hi + ((lane & 15) >> 2)) * 64;
#define A_SCHED __builtin_amdgcn_sched_barrier(0)
#define A_STEP(C0, C1, N0, N1, T_) do { \
                    if ((T_) + 3 < NT) { kreg = *(const u32x4*)(kp + (size_t)((T_) + 3) * 64 * NEP); vreg = *(const u32x4*)(vp + (size_t)((T_) + 3) * 64 * NEP); } \
                    bf16x8 kf[4], kg[4]; \
                    { _Pragma("unroll") for (int d0 = 0; d0 < 2; ++d0) { LAS const unsigned char* kb_ = lds + bnxt + (2 * d0 + hi) * 1024 + ((r32 ^ (2 * d0 + hi)) * 16); asm volatile("" : "+v"(kb_)); \
                        kf[2 * d0] = *(LAS const bf16x8*)(kb_); kf[2 * d0 + 1] = *(LAS const bf16x8*)(kb_ + 512); } } \
                    A_SCHED; \
                    { _Pragma("unroll") for (int d0 = 2; d0 < 4; ++d0) { LAS const unsigned char* kb_ = lds + bnxt + (2 * d0 + hi) * 1024 + ((r32 ^ (2 * d0 + hi)) * 16); asm volatile("" : "+v"(kb_)); \
                        kg[2 * d0 - 4] = *(LAS const bf16x8*)(kb_); kg[2 * d0 - 3] = *(LAS const bf16x8*)(kb_ + 512); } } \
                    N0 = __builtin_amdgcn_mfma_f32_32x32x16_bf16(kf[0], qr[0], (f32x16){}, 0, 0, 0); N1 = __builtin_amdgcn_mfma_f32_32x32x16_bf16(kf[1], qr[0], (f32x16){}, 0, 0, 0); \
                    N0 = __builtin_amdgcn_mfma_f32_32x32x16_bf16(kf[2], qr[1], N0, 0, 0, 0);   N1 = __builtin_amdgcn_mfma_f32_32x32x16_bf16(kf[3], qr[1], N1, 0, 0, 0); \
                    A_SCHED; \
                    N0 = __builtin_amdgcn_mfma_f32_32x32x16_bf16(kg[0], qr[2], N0, 0, 0, 0);   N1 = __builtin_amdgcn_mfma_f32_32x32x16_bf16(kg[1], qr[2], N1, 0, 0, 0); \
                    N0 = __builtin_amdgcn_mfma_f32_32x32x16_bf16(kg[2], qr[3], N0, 0, 0, 0);   N1 = __builtin_amdgcn_mfma_f32_32x32x16_bf16(kg[3], qr[3], N1, 0, 0, 0); \
                    A_SCHED; \
                    s16x4 vlo[4], vhi[4]; \
                    { LAS const unsigned char* vp_ = lds + bcur + 8192 + vbl; asm volatile("" : "+v"(vp_)); \
                      _Pragma("unroll") for (int i = 0; i < 4; ++i) { vlo[i] = vtr(vp_ + (i & 3) * 1024); vhi[i] = vtr(vp_ + (i & 3) * 1024 + 512); } } \
                    A_SCHED; \
                    float s_ = 0.f; \
                    _Pragma("unroll") for (int r = 0; r < 16; ++r) { C0[r] = __builtin_amdgcn_exp2f(C0[r]); C1[r] = __builtin_amdgcn_exp2f(C1[r]); s_ += C0[r] + C1[r]; } \
                    l += s_; \
                    bf16x8 pa[4]; \
                    { u32x4 w; \
                      w = (u32x4){cvtpk(C0[0], C0[1]), cvtpk(C0[2], C0[3]), cvtpk(C0[4], C0[5]), cvtpk(C0[6], C0[7])}; pa[0] = __builtin_bit_cast(bf16x8, w); \
                      w = (u32x4){cvtpk(C0[8], C0[9]), cvtpk(C0[10], C0[11]), cvtpk(C0[12], C0[13]), cvtpk(C0[14], C0[15])}; pa[1] = __builtin_bit_cast(bf16x8, w); \
                      w = (u32x4){cvtpk(C1[0], C1[1]), cvtpk(C1[2], C1[3]), cvtpk(C1[4], C1[5]), cvtpk(C1[6], C1[7])}; pa[2] = __builtin_bit_cast(bf16x8, w); \
                      w = (u32x4){cvtpk(C1[8], C1[9]), cvtpk(C1[10], C1[11]), cvtpk(C1[12], C1[13]), cvtpk(C1[14], C1[15])}; pa[3] = __builtin_bit_cast(bf16x8, w); } \
                    A_SCHED; \
                    _Pragma("unroll") for (int i = 0; i < 4; ++i) { const bf16x8 vf = (bf16x8){vlo[i][0], vlo[i][1], vlo[i][2], vlo[i][3], vhi[i][0], vhi[i][1], vhi[i][2], vhi[i][3]}; \
                        o[0] = __builtin_amdgcn_mfma_f32_32x32x16_bf16(pa[i], vf, o[0], 0, 0, 0); } \
                    A_SCHED; \
                    { LAS const unsigned char* vp_ = lds + bcur + 8192 + 4096 + vbl; asm volatile("" : "+v"(vp_)); \
                      _Pragma("unroll") for (int i = 0; i < 4; ++i) { vlo[i] = vtr(vp_ + i * 1024); vhi[i] = vtr(vp_ + i * 1024 + 512); } } \
                    if ((T_) + 3 < NT) { *(LAS u32x4*)(lds + bnn + kdst) = kreg; *(LAS u32x4*)(lds + bnn + vdst) = vreg; } \
                    A_SCHED; \
                    _Pragma("unroll") for (int i = 0; i < 4; ++i) { const bf16x8 vf = (bf16x8){vlo[i][0], vlo[i][1], vlo[i][2], vlo[i][3], vhi[i][0], vhi[i][1], vhi[i][2], vhi[i][3]}; \
                        o[1] = __builtin_amdgcn_mfma_f32_32x32x16_bf16(pa[i], vf, o[1], 0, 0, 0); } \
                    if (BAR_) __syncthreads(); \
                    bcur = bnxt; bnxt = (bnxt == 65536u) ? 0u : bnxt + 16384u; bnn = (bnn == 65536u) ? 0u : bnn + 16384u; \
                } while (0)
                for (int t = 0; t < NT; t += 2) {
#define BAR_ false
                    A_STEP(sa0, sa1, sb0, sb1, t);
#undef BAR_
#define BAR_ true
                    A_STEP(sb0, sb1, sa0, sa1, t + 1);
#undef BAR_
                }
#undef A_STEP
#undef A_SCHED
                flash_finish(o, l, wsf, stg, OB + (rowbase + q0) * DM + h * 64, DM, lane);
            }
        } else if (s == 8 && (PHM & 64)) {
            const int nib = S >> 9, nqb = S >> 5;
            LAS unsigned char* wl = lds + wave * 16384;
            float* LSE = (float*)(ws + WS_LSE);
            for (int pass = 0; pass < 2; ++pass) {
            const int ntask = pass == 0 ? nb * 16 * nqb : nb * 16 * nib * 16;
            const int qstep = pass == 0 ? 1 : 16, ubeg = pass == 0 ? 0 : 10, uend = pass == 0 ? 3 : 17;
            for (int wt = gw; wt < ntask; wt += NGW) {
                int tmin, h, b;
                if (pass == 0) { const int qb = wt % nqb, bh = wt / nqb; h = bh & 15; b = bh >> 4; tmin = qb * 32; }
                else { const int rho = wt & 15, ib = (wt >> 4) % nib, bh = (wt >> 4) / nib; h = bh & 15; b = bh >> 4; tmin = rho + 512 * ib; }
                const size_t rowbase = (size_t)b * S;
                const int tq = tmin + qstep * r32;
                const float slope2 = __builtin_amdgcn_exp2f(-0.5f * (float)(h + 1)) * LOG2E;
                const bf16_t* qp = QKV + (rowbase + tq) * NOP + h * 64 + hi * 8;
                bf16x8 qr[4];
#pragma unroll
                for (int d0 = 0; d0 < 4; ++d0) qr[d0] = *(const bf16x8*)(qp + d0 * 16);
                f32x16 o[2]; o[0] = (f32x16){}; o[1] = (f32x16){}; f32x16 negm = (f32x16){}; float mref = 0.f, l = 0.f;
                const int lrow = lane >> 3, ch = lane & 7;
                const int lrowV = 2 * (lane >> 4) + ((lane >> 2) & 1), dhV = (lane >> 3) & 1, cwV = lane & 3;
                const bf16_t* kb = QKV + rowbase * NOP + 1024 + h * 64 + ch * 8;
                const bf16_t* vb = QKV + rowbase * NOP + 2048 + h * 64 + dhV * 32 + cwV * 8;
                u32x4 kr[8], vr[8];
#define DIL_TILE(u, SH, T0) do { const int g_ = (u) < 10 ? 0 : ((u) < 14 ? 1 : 2); SH = 2 * g_; const int tt_ = (u) - (g_ == 0 ? 0 : (g_ == 1 ? 10 : 14)); T0 = tmin - (64 << SH) + ((64 * tt_) << SH); } while (0)
#define DIL_LOADK(SH, T0) do { int lr_ = lrow; asm volatile("" : "+v"(lr_)); _Pragma("unroll") for (int j = 0; j < 8; ++j) { const int tk_ = min(max(T0 + ((lr_ + 8 * j) << SH), 0), S - 1); kr[j] = *(const u32x4*)(kb + (size_t)tk_ * NOP); } } while (0)
#define DIL_LOADV(SH, T0) do { int lr_ = lrowV; asm volatile("" : "+v"(lr_)); _Pragma("unroll") for (int j = 0; j < 8; ++j) { const int tv_ = min(max(T0 + ((lr_ + 8 * j) << SH), 0), S - 1); vr[j] = *(const u32x4*)(vb + (size_t)tv_ * NOP); } } while (0)
                int sh, t0; DIL_TILE(ubeg, sh, t0); DIL_LOADK(sh, t0); DIL_LOADV(sh, t0);
                for (int u = ubeg; u < uend; ++u) {
                    LAS unsigned char* kw = wl + ch * 1024 + (lrow ^ ch) * 16; LAS unsigned char* vw = wl + 8192 + dhV * 4096 + lrowV * 64 + cwV * 16; asm volatile("" : "+v"(kw), "+v"(vw));
#pragma unroll
                    for (int j = 0; j < 8; ++j) { *(LAS u32x4*)(kw + j * 128) = kr[j]; *(LAS u32x4*)(vw + j * 512) = vr[j]; }
                    int tq_ = tq; asm volatile("" : "+v"(tq_));
                    ModDil mod{(float)(tq_ - t0 - ((4 * hi) << sh)), (float)(1 << sh), (float)(64 << sh), slope2, (float)tq_, (float)(tq_ - S), (t0 >= 0) && (t0 + (63 << sh) < S)};
                    bf16x8 pa[4];
                    if (u + 1 < uend) { DIL_TILE(u + 1, sh, t0); DIL_LOADK(sh, t0); }
                    f32x16 s0, s1;
                    qkt2(s0, s1, wl, qr, negm, r32, hi);
                    softmax2<false>(s0, s1, o, negm, mref, l, wsf, lane, mod, pa, s0, s1);
                    asm volatile("" ::: "memory");
                    if (u + 1 < uend) { DIL_LOADV(sh, t0); }
                    pv_lane(o, wl + 8192, pa, lane);
                    asm volatile("" ::: "memory");
                }
#undef DIL_TILE
#undef DIL_LOADK
#undef DIL_LOADV
                flash_finish_c(o, l, mref, wsf, wl, OB + (rowbase + tmin) * DM + h * 64, (size_t)qstep * DM, lane, LSE + (rowbase + tmin) * 16 + h, qstep * 16, pass == 1);
            }
            if (pass == 0) xcd_barrier(xbar);
            }
        }
        if (ph == 0) grid.sync(); else if (ph < 24) xcd_barrier(xbar);
    }
}

#undef KA
extern "C" void kernel_launch(void* const* d_in, const int* in_sizes, int n_in, void* d_out, int out_size, void* d_ws, size_t ws_size, hipStream_t stream) {
    static int grid_blocks = 0;
    if (!grid_blocks) {
        int dev = 0, cus = 0, per_cu = 0;
        hipGetDevice(&dev);
        hipDeviceGetAttribute(&cus, hipDeviceAttributeMultiprocessorCount, dev);
        hipFuncSetAttribute((const void*)fwd_megakernel, hipFuncAttributeMaxDynamicSharedMemorySize, LDS_BYTES);
        hipOccupancyMaxActiveBlocksPerMultiprocessor(&per_cu, (const void*)fwd_megakernel, NTHREADS, LDS_BYTES);
        if (per_cu < 1) per_cu = 1;
        grid_blocks = cus * per_cu;
        if (n_in != 14 || ws_size < WS_END) fprintf(stderr, "kernel_launch: unexpected n_in %d / ws_size %zu\n", n_in, ws_size);
    }
    (void)hipMemsetAsync((char*)d_ws + WS_BAR, 0, 16384, stream);
    Params p{};
    for (int i = 0; i < 14; ++i) p.in[i] = (const float*)d_in[i];
    p.out = (float*)d_out; p.ws = (unsigned char*)d_ws;
    void* args[] = {&p};
    hipError_t e = hipLaunchCooperativeKernel((const void*)fwd_megakernel, dim3(grid_blocks), dim3(NTHREADS), args, LDS_BYTES, stream);
    if (e != hipSuccess) fprintf(stderr, "cooperative launch failed: %s (grid %d)\n", hipGetErrorString(e), grid_blocks);
}
```

```cpp
#include <hip/hip_runtime.h>
#include <hip/hip_cooperative_groups.h>
#include <cstdio>
#include <cstdint>
namespace cg = cooperative_groups;

#define LAS __attribute__((address_space(3)))
typedef unsigned short bf16_t;
typedef short bf16x8 __attribute__((ext_vector_type(8)));
typedef short s16x4 __attribute__((ext_vector_type(4)));
typedef float f32x2 __attribute__((ext_vector_type(2)));
typedef float f32x4 __attribute__((ext_vector_type(4)));
typedef float f32x16 __attribute__((ext_vector_type(16)));
typedef unsigned u32x2 __attribute__((ext_vector_type(2)));
typedef unsigned u32x4 __attribute__((ext_vector_type(4)));
typedef __bf16 bf16x2_t __attribute__((ext_vector_type(2)));

constexpr int DM = 1024, DFF = 2816, RC = 65536;
constexpr int NE = 2304, NO = 3072, NGU = 5632;
constexpr int NEP = NE + 64, NOP = NO + 64;
constexpr float EPS = 1e-6f, LOG2E = 1.4426950408889634f, C2 = 0.125f * 1.4426950408889634f;
constexpr int NTHREADS = 512, NWAVES = 8;
#ifndef PHM
#define PHM 127
#endif
#ifndef DUP
#define DUP 0
#endif

constexpr size_t MiB = 1u << 20;
constexpr size_t WS_ROPE = 0;
constexpr size_t WS_BAR = 65536;
constexpr size_t WS_SSQ = 1 * MiB;
constexpr size_t WS_W = 4 * MiB;
constexpr size_t W_INE = WS_W, W_OUTE = W_INE + (size_t)NE * DM * 2, W_INO = W_OUTE + (size_t)DM * DM * 2, W_OUTO = W_INO + (size_t)NO * DM * 2;
constexpr size_t W_GU0 = W_OUTO + (size_t)DM * DM * 2, W_GU1 = W_GU0 + (size_t)NGU * DM * 2, W_DN0 = W_GU1 + (size_t)NGU * DM * 2, W_DN1 = W_DN0 + (size_t)DM * DFF * 2;
constexpr size_t W_END = W_DN1 + (size_t)DM * DFF * 2;
constexpr size_t WS_XB = 52 * MiB;
constexpr size_t WS_QKV = 180 * MiB;
constexpr size_t WS_H = 180 * MiB;
constexpr size_t WS_O = 576 * MiB;
constexpr size_t WS_XB1 = 704 * MiB;
constexpr size_t WS_LSE = 832 * MiB;
constexpr size_t WS_END = 836 * MiB;
static_assert(W_END <= WS_XB, "weights fit");
static_assert(WS_QKV + (size_t)RC * NOP * 2 <= WS_O && WS_H + (size_t)RC * DFF * 2 <= WS_O, "qkv/h fit");

constexpr int RING_BYTES = 131072;
constexpr int WSF_OFF = RING_BYTES;
constexpr int RPB_OFF = WSF_OFF + 2048;
constexpr int PTAB_OFF = 148736;
constexpr int LDS_BYTES = 151552;
static_assert(RPB_OFF + 3720 * 4 + 512 <= PTAB_OFF && PTAB_OFF + 128 <= LDS_BYTES, "lds map");
__device__ __forceinline__ const float* ldptr(LAS const unsigned long long* tab, int i) {
    const unsigned long long v = tab[i];
    const unsigned lo = __builtin_amdgcn_readfirstlane((unsigned)v), hi = __builtin_amdgcn_readfirstlane((unsigned)(v >> 32));
    return (const float*)(((unsigned long long)hi << 32) | lo);
}

__device__ __forceinline__ unsigned cvtpk(float lo, float hi) { f32x2 v = {lo, hi}; bf16x2_t b = __builtin_convertvector(v, bf16x2_t); return __builtin_bit_cast(unsigned, b); }
__device__ __forceinline__ float bf2f(unsigned short h) { return __builtin_bit_cast(float, (unsigned)h << 16); }
__device__ __forceinline__ float wave_sum(float v) {
#pragma unroll
    for (int o = 1; o < 64; o <<= 1) v += __shfl_xor(v, o);
    return v;
}

namespace pg8 {
constexpr int BM = 256, BK = 64, HALF = 128, HTB = HALF * BK * 2, STAGE_BYTES = 8 * HTB, NXCD = 8, WGM = 8;
__host__ __device__ __forceinline__ int lds_byte(int r, int c) { const int st = (r >> 4) * 2 + (c >> 5), rr = r & 15, cc = c & 31, ob = rr * 64 + cc * 2; return st * 1024 + (ob ^ (((ob >> 9) & 1) << 5)); }
__host__ __device__ __forceinline__ void stage_rc(int b, int& R, int& C) { const int st = b / 1024, sb = b % 1024, swz = sb ^ (((sb >> 9) & 1) << 5); R = (st >> 1) * 16 + swz / 64; C = (st & 1) * 32 + (swz % 64) / 2; }
__host__ __device__ __forceinline__ int perm32(int rho) { const int n = rho >> 4, i = rho & 15; return 8 * (i >> 2) + 4 * n + (i & 3); }
struct Unit { int pm, pn; };
struct Gemm { const bf16_t* A; const bf16_t* Bt; int M, N, K; };
struct StaticOrder {
    int nM, nN, nwg, G, c;
    __host__ __device__ void init(int M, int N, int G_, int c_) { nM = M / BM; nN = N / BM; nwg = nM * nN; G = G_; c = c_; }
    __host__ __device__ bool next(int i, Unit& u) const {
        const long L = (long)i * G + c; if (L >= nwg) return false;
        int wgid = (int)L; { const int q = nwg / NXCD, r = nwg % NXCD, xcd = wgid % NXCD, off = wgid / NXCD; wgid = (xcd < r ? xcd * (q + 1) : r * (q + 1) + (xcd - r) * q) + off; }
        const int nig = WGM * nN, gid = wgid / nig, fm = gid * WGM, gsz = (nM - fm) < WGM ? (nM - fm) : WGM;
        u.pm = fm + ((wgid % nig) % gsz); u.pn = (wgid % nig) / gsz; return true;
    }
};

struct EpiScaleBf16 {
    static constexpr bool PERM = true;
    bf16_t* O; int ldc; const float* ssq; int t0, t1; float tscale;
    __device__ __forceinline__ void pre(const Unit& u, int wr, int fr, float (&pv)[8]) const {
        const int row0 = u.pm * BM + wr * 64 + fr;
#pragma unroll
        for (int i = 0; i < 8; ++i) pv[i] = ssq[row0 + (i >> 2) * HALF + (i & 3) * 16];
    }
    __device__ __forceinline__ void operator()(const f32x4 (&acc)[2][2][4][2], const Unit& u, int wr, int wc, int fr, int fq, const float (&pv)[8]) const {
        const int row0 = u.pm * BM + wr * 64 + fr, col0 = u.pn * BM + wc * 32 + 8 * fq;
        const float sc = (u.pn >= t0 && u.pn < t1) ? tscale : 1.f;
#pragma unroll
        for (int ai = 0; ai < 2; ++ai)
#pragma unroll
            for (int m = 0; m < 4; ++m) { const int row = row0 + ai * HALF + m * 16; const float rs = __builtin_amdgcn_rsqf(pv[ai * 4 + m] * (1.f / DM) + EPS) * sc;
                bf16_t* rowp = O + (size_t)row * ldc + col0;
#pragma unroll
                for (int bj = 0; bj < 2; ++bj) { const f32x4 v0 = acc[ai][bj][m][0] * rs, v1 = acc[ai][bj][m][1] * rs;
                    u32x4 w; w.x = cvtpk(v0[0], v0[1]); w.y = cvtpk(v0[2], v0[3]); w.z = cvtpk(v1[0], v1[1]); w.w = cvtpk(v1[2], v1[3]);
                    *(u32x4*)(rowp + bj * HALF) = w; } }
    }
};
struct EpiSwiGLU {
    static constexpr bool PERM = true;
    bf16_t* H; const float* ssq;
    __device__ __forceinline__ void pre(const Unit& u, int wr, int fr, float (&pv)[8]) const {
        const int row0 = u.pm * BM + wr * 64 + fr;
#pragma unroll
        for (int i = 0; i < 8; ++i) pv[i] = ssq[row0 + (i >> 2) * HALF + (i & 3) * 16];
    }
    __device__ __forceinline__ void operator()(const f32x4 (&acc)[2][2][4][2], const Unit& u, int wr, int wc, int fr, int fq, const float (&pv)[8]) const {
        const int row0 = u.pm * BM + wr * 64 + fr, col0 = u.pn * HALF + wc * 32 + 8 * fq;
#pragma unroll
        for (int ai = 0; ai < 2; ++ai)
#pragma unroll
            for (int m = 0; m < 4; ++m) { const int row = row0 + ai * HALF + m * 16; const float rs = __builtin_amdgcn_rsqf(pv[ai * 4 + m] * (1.f / DM) + EPS);
                float hv[8];
#pragma unroll
                for (int n = 0; n < 2; ++n)
#pragma unroll
                    for (int j = 0; j < 4; ++j) { const float g = acc[ai][0][m][n][j] * rs, uu = acc[ai][1][m][n][j] * rs;
                        const float e = __builtin_amdgcn_exp2f(-g * LOG2E); hv[n * 4 + j] = g * uu * __builtin_amdgcn_rcpf(1.f + e); }
                u32x4 w; w.x = cvtpk(hv[0], hv[1]); w.y = cvtpk(hv[2], hv[3]); w.z = cvtpk(hv[4], hv[5]); w.w = cvtpk(hv[6], hv[7]);
                *(u32x4*)(H + (size_t)row * DFF + col0) = w; }
    }
};
struct EpiResidual {
    static constexpr bool PERM = true;
    bf16_t* xb; float* ssq;
    __device__ __forceinline__ void pre(const Unit&, int, int, float (&)[8]) const {}
    __device__ __forceinline__ void operator()(const f32x4 (&acc)[2][2][4][2], const Unit& u, int wr, int wc, int fr, int fq, const float (&)[8]) const {
        const int row0 = u.pm * BM + wr * 64 + fr, col0 = u.pn * BM + wc * 32 + 8 * fq;
#pragma unroll
        for (int ai = 0; ai < 2; ++ai)
#pragma unroll
            for (int m = 0; m < 4; ++m) { const int row = row0 + ai * HALF + m * 16; bf16_t* rowp = xb + (size_t)row * DM + col0; float s = 0.f;
                u32x4 raw[2];
#pragma unroll
                for (int bj = 0; bj < 2; ++bj) raw[bj] = *(const u32x4*)(rowp + bj * HALF);
#pragma unroll
                for (int bj = 0; bj < 2; ++bj) { const f32x4 a0 = acc[ai][bj][m][0], a1 = acc[ai][bj][m][1]; const u32x4 r = raw[bj];
                    const float x0 = __builtin_bit_cast(float, r.x << 16) + a0[0], x1 = __builtin_bit_cast(float, r.x & 0xffff0000u) + a0[1];
                    const float x2 = __builtin_bit_cast(float, r.y << 16) + a0[2], x3 = __builtin_bit_cast(float, r.y & 0xffff0000u) + a0[3];
                    const float x4 = __builtin_bit_cast(float, r.z << 16) + a1[0], x5 = __builtin_bit_cast(float, r.z & 0xffff0000u) + a1[1];
                    const float x6 = __builtin_bit_cast(float, r.w << 16) + a1[2], x7 = __builtin_bit_cast(float, r.w & 0xffff0000u) + a1[3];
                    u32x4 w; w.x = cvtpk(x0, x1); w.y = cvtpk(x2, x3); w.z = cvtpk(x4, x5); w.w = cvtpk(x6, x7);
                    *(u32x4*)(rowp + bj * HALF) = w;
                    s += ((x0 * x0 + x1 * x1) + (x2 * x2 + x3 * x3)) + ((x4 * x4 + x5 * x5) + (x6 * x6 + x7 * x7)); }
                s += __shfl_xor(s, 16); s += __shfl_xor(s, 32);
                if (fq == 0) atomicAdd(ssq + row, s); }
    }
};

template <class Epi>
__device__ __forceinline__ void gemm_phase(LAS unsigned char* lds, const Gemm g, const StaticOrder& S, const Epi& E, const int wave_id) {
    int tid = threadIdx.x; asm volatile("" : "+v"(tid));
    const int wid = __builtin_amdgcn_readfirstlane(tid >> 6), lane = tid & 63, wr = wid >> 2, wc = wid & 3, fr = lane & 15, fq = lane >> 4;
    const int K = g.K, nt = K / BK;
    unsigned voffA[2], voffB[2];
#pragma unroll
    for (int i = 0; i < 2; ++i) { int R, C; stage_rc(tid * 16 + i * 8192, R, C); const int Rb = Epi::PERM ? ((R & ~31) + perm32(R & 31)) : R;
        voffA[i] = (unsigned)(R * K + C) * 2u; voffB[i] = (unsigned)(Rb * K + C) * 2u; }
    const size_t kstep = (size_t)(BK * 2);
    const size_t hstep = (size_t)HALF * K * 2;
    const size_t tstep = 2 * hstep;
    const unsigned ldsw = (unsigned)wid * 1024u;
    const int aoff = lds_byte(wr * 64 + fr, fq * 8), boff = lds_byte(wc * 32 + fr, fq * 8);
#define PG8_SA(b, h) (((b) * 2 + (h)) * HTB)
#define PG8_SB(b, h) ((4 + (b) * 2 + (h)) * HTB)
#define PG8_STAGE(bufoff, gbase, voff) do { _Pragma("unroll") for (int _i = 0; _i < 2; ++_i) \
        __builtin_amdgcn_global_load_lds((const unsigned*)((const char*)(gbase) + (voff)[_i]), (LAS unsigned*)(lds + (bufoff) + ldsw + _i * 8192), 16, 0, 0); } while (0)
#define PG8_LDA(dst, b, h) do { _Pragma("unroll") for (int m = 0; m < 4; ++m) _Pragma("unroll") for (int k = 0; k < 2; ++k) dst[m][k] = *(const LAS bf16x8*)(lds + PG8_SA(b, h) + aoff + m * 2048 + k * 1024); } while (0)
#define PG8_LDB(dst, b, h) do { _Pragma("unroll") for (int n = 0; n < 2; ++n) _Pragma("unroll") for (int k = 0; k < 2; ++k) dst[n][k] = *(const LAS bf16x8*)(lds + PG8_SB(b, h) + boff + n * 2048 + k * 1024); } while (0)
#define PG8_MMA(ai, bj, At, Bt) do { __builtin_amdgcn_s_setprio(1); _Pragma("unroll") for (int m = 0; m < 4; ++m) _Pragma("unroll") for (int n = 0; n < 2; ++n) _Pragma("unroll") for (int k = 0; k < 2; ++k) \
        acc[ai][bj][m][n] = __builtin_amdgcn_mfma_f32_16x16x32_bf16(Bt[n][k], At[m][k], acc[ai][bj][m][n], 0, 0, 0); __builtin_amdgcn_s_setprio(0); } while (0)
#define PG8_WAIT_V(n) asm volatile("s_waitcnt vmcnt(" #n ")" ::: "memory")
#define PG8_WAIT_L(n) asm volatile("s_waitcnt lgkmcnt(" #n ")" ::: "memory")
#define PG8_BAR __builtin_amdgcn_s_barrier()
#define PG8_SCHED __builtin_amdgcn_sched_barrier(0)
    Unit cur, nxt; int ui = 0;
    if (!S.next(0, cur)) return;
    f32x4 acc[2][2][4][2];
#pragma unroll
    for (int a = 0; a < 2; ++a)
#pragma unroll
        for (int b = 0; b < 2; ++b)
#pragma unroll
            for (int m = 0; m < 4; ++m)
#pragma unroll
                for (int n = 0; n < 2; ++n) acc[a][b][m][n] = (f32x4){0.f, 0.f, 0.f, 0.f};
    bf16x8 At[4][2], B0[2][2], B1[2][2];
    float epre[8] = {0.f, 0.f, 0.f, 0.f, 0.f, 0.f, 0.f, 0.f};
    const char* cA = (const char*)g.A + (size_t)cur.pm * tstep; const char* cB = (const char*)g.Bt + (size_t)cur.pn * tstep;
    PG8_STAGE(PG8_SB(0, 0), cB, voffB); PG8_STAGE(PG8_SB(0, 1), cB + hstep, voffB); PG8_STAGE(PG8_SA(0, 0), cA, voffA); PG8_STAGE(PG8_SA(0, 1), cA + hstep, voffA);
    if (wr == 1) PG8_BAR;
    PG8_WAIT_V(2); PG8_BAR;
    PG8_STAGE(PG8_SB(1, 0), cB + kstep, voffB); PG8_STAGE(PG8_SA(1, 0), cA + kstep, voffA); PG8_STAGE(PG8_SB(1, 1), cB + hstep + kstep, voffB);
    PG8_WAIT_V(6); PG8_BAR;
    for (;;) {
        const bool has_next = S.next(ui + 1, nxt);
        const char* nA = has_next ? (const char*)g.A + (size_t)nxt.pm * tstep : cA; const char* nB = has_next ? (const char*)g.Bt + (size_t)nxt.pn * tstep : cB;
        for (int t = 0; t < nt; t += 2) {
            const bool last = (t == nt - 2);
            if (last) E.pre(cur, wr, fr, epre);
            const char* a1 = cA + (size_t)(t + 1) * kstep;
            const char* a2 = last ? nA : cA + (size_t)(t + 2) * kstep; const char* b2 = last ? nB : cB + (size_t)(t + 2) * kstep;
            const char* a3 = a2 + kstep; const char* b3 = b2 + kstep;
            PG8_LDB(B0, 0, 0); PG8_LDB(B1, 0, 1); PG8_SCHED; PG8_LDA(At, 0, 0); PG8_STAGE(PG8_SA(1, 1), a1 + hstep, voffA);
            PG8_WAIT_V(8); PG8_WAIT_L(0); PG8_BAR; PG8_MMA(0, 0, At, B0); PG8_MMA(0, 1, At, B1); PG8_BAR; PG8_SCHED;
            PG8_LDA(At, 0, 1); PG8_STAGE(PG8_SB(0, 0), b2, voffB); PG8_STAGE(PG8_SB(0, 1), b2 + hstep, voffB); PG8_STAGE(PG8_SA(0, 0), a2, voffA);
            PG8_WAIT_V(8); PG8_WAIT_L(0); PG8_BAR; PG8_MMA(1, 0, At, B0); PG8_MMA(1, 1, At, B1); PG8_BAR; PG8_SCHED;
            PG8_LDB(B0, 1, 0); PG8_LDB(B1, 1, 1); PG8_SCHED; PG8_LDA(At, 1, 0); PG8_STAGE(PG8_SA(0, 1), a2 + hstep, voffA);
            PG8_WAIT_V(8); PG8_WAIT_L(0); PG8_BAR; PG8_MMA(0, 0, At, B0); PG8_MMA(0, 1, At, B1); PG8_BAR; PG8_SCHED;
            PG8_LDA(At, 1, 1); PG8_STAGE(PG8_SB(1, 0), b3, voffB); PG8_STAGE(PG8_SB(1, 1), b3 + hstep, voffB); PG8_STAGE(PG8_SA(1, 0), a3, voffA);
            PG8_WAIT_V(8); PG8_WAIT_L(0); PG8_BAR; PG8_MMA(1, 0, At, B0); PG8_MMA(1, 1, At, B1); PG8_BAR; PG8_SCHED;
        }
        if (wr == 0) PG8_BAR;
        E(acc, cur, wr, wc, fr, fq, epre);
        if (!has_next) break;
#pragma unroll
        for (int a = 0; a < 2; ++a)
#pragma unroll
            for (int b = 0; b < 2; ++b)
#pragma unroll
                for (int m = 0; m < 4; ++m)
#pragma unroll
                    for (int n = 0; n < 2; ++n) acc[a][b][m][n] = (f32x4){0.f, 0.f, 0.f, 0.f};
        cur = nxt; cA = nA; cB = nB; ++ui;
        if (wr == 1) PG8_BAR;
    }
    PG8_WAIT_V(0);
    PG8_BAR;
#undef PG8_SA
#undef PG8_SB
#undef PG8_STAGE
#undef PG8_LDA
#undef PG8_LDB
#undef PG8_MMA
#undef PG8_WAIT_V
#undef PG8_WAIT_L
#undef PG8_BAR
#undef PG8_SCHED
}
}

__device__ __forceinline__ void qkt(f32x16& p0, f32x16& p1, LAS const unsigned char* kslot, const bf16x8 (&qr)[4], int r32, int hi) {
    p0 = (f32x16){}; p1 = (f32x16){};
#pragma unroll
    for (int d0 = 0; d0 < 4; ++d0) {
        LAS const unsigned char* kb = kslot + (2 * d0 + hi) * 1024 + ((r32 ^ (2 * d0 + hi)) * 16); asm volatile("" : "+v"(kb));
        const bf16x8 b0 = *(LAS const bf16x8*)(kb);
        const bf16x8 b1 = *(LAS const bf16x8*)(kb + 512);
        p0 = __builtin_amdgcn_mfma_f32_32x32x16_bf16(b0, qr[d0], p0, 0, 0, 0);
        p1 = __builtin_amdgcn_mfma_f32_32x32x16_bf16(b1, qr[d0], p1, 0, 0, 0);
    }
}
__device__ __forceinline__ s16x4 vtr(LAS const unsigned char* p) { return __builtin_bit_cast(s16x4, __builtin_amdgcn_ds_read_tr16_b64_v4i16((LAS s16x4*)p)); }
__device__ __forceinline__ void pv(f32x16 (&o)[2], LAS const unsigned char* vp, const bf16x8 (&pa)[4]) {
    asm volatile("" : "+v"(vp));
#pragma unroll
    for (int d0 = 0; d0 < 2; ++d0)
#pragma unroll
        for (int ks = 0; ks < 4; ++ks) {
            const s16x4 lo = vtr(vp + d0 * 4096 + ks * 1024), hh = vtr(vp + d0 * 4096 + ks * 1024 + 512);
            const bf16x8 vf = (bf16x8){lo[0], lo[1], lo[2], lo[3], hh[0], hh[1], hh[2], hh[3]};
            o[d0] = __builtin_amdgcn_mfma_f32_32x32x16_bf16(pa[ks], vf, o[d0], 0, 0, 0);
        }
}
struct ModNone { __device__ __forceinline__ void apply(f32x16&, f32x16&, int, int) const {} };
struct ModNA {
    int kcs; LAS const float* tl;
    __device__ __forceinline__ void apply(f32x16& p0, f32x16& p1, int, int) const {
#pragma unroll
        for (int r = 0; r < 16; ++r) { constexpr int dummy = 0; (void)dummy; const int cr = (r & 3) + 8 * (r >> 2);
            { const float v = p0[r] + tl[cr]; p0[r] = ((unsigned)(cr + kcs) < 16u) ? v : -INFINITY; }
            { const float v = p1[r] + tl[cr + 32]; p1[r] = ((unsigned)(cr + 32 + kcs) < 16u) ? v : -INFINITY; } }
    }
};
struct ModDil {
    float af, strf, limf, slope2, tqf, tqmS; bool inb;
    __device__ __forceinline__ void apply(f32x16& p0, f32x16& p1, int, int) const {
        if (inb) {
#pragma unroll
            for (int r = 0; r < 16; ++r) { const float cr = (float)((r & 3) + 8 * (r >> 2));
                { const float d = __builtin_fmaf(-cr, strf, af); const float v = __builtin_fmaf(-slope2, __builtin_fabsf(d), p0[r]); p0[r] = (__builtin_fabsf(d) <= limf) ? v : -INFINITY; }
                { const float d = __builtin_fmaf(-(cr + 32.f), strf, af); const float v = __builtin_fmaf(-slope2, __builtin_fabsf(d), p1[r]); p1[r] = (__builtin_fabsf(d) <= limf) ? v : -INFINITY; } }
        } else {
#pragma unroll
            for (int r = 0; r < 16; ++r) { const float cr = (float)((r & 3) + 8 * (r >> 2));
                { const float d = __builtin_fmaf(-cr, strf, af); const float v = __builtin_fmaf(-slope2, __builtin_fabsf(d), p0[r]); p0[r] = ((__builtin_fabsf(d) <= limf) && (d <= tqf) && (d > tqmS)) ? v : -INFINITY; }
                { const float d = __builtin_fmaf(-(cr + 32.f), strf, af); const float v = __builtin_fmaf(-slope2, __builtin_fabsf(d), p1[r]); p1[r] = ((__builtin_fabsf(d) <= limf) && (d <= tqf) && (d > tqmS)) ? v : -INFINITY; } }
        }
    }
};
template <class Mod>
__device__ __forceinline__ void flash_step(LAS const unsigned char* kslot, LAS const unsigned char* vslot, const bf16x8 (&qr)[4], f32x16 (&o)[2], float& m, float& l, LAS float* wsf, int lane, const Mod& mod) {
    const int r32 = lane & 31, hi = lane >> 5;
    f32x16 p0, p1; qkt(p0, p1, kslot, qr, r32, hi);
    mod.apply(p0, p1, r32, hi);
    float rm = fmaxf(p0[0], p1[0]);
#pragma unroll
    for (int r = 1; r < 16; ++r) rm = fmaxf(rm, fmaxf(p0[r], p1[r]));
    rm = fmaxf(rm, __shfl_xor(rm, 32));
    const float mn = fmaxf(m, rm); const float alpha = __builtin_amdgcn_exp2f(m - mn); m = mn;
    float s = 0.f;
#pragma unroll
    for (int r = 0; r < 16; ++r) { p0[r] = __builtin_amdgcn_exp2f(p0[r] - mn); p1[r] = __builtin_amdgcn_exp2f(p1[r] - mn); s += p0[r] + p1[r]; }
    l = l * alpha + s;
    { LAS float* ww = wsf + r32; asm volatile("" : "+v"(ww)); if (hi == 0) *ww = alpha; }
    asm volatile("" ::: "memory");
    LAS const float* wr_ = wsf + 4 * hi; asm volatile("" : "+v"(wr_));
#pragma unroll
    for (int k = 0; k < 4; ++k) { const f32x4 a = *(LAS const f32x4*)(wr_ + 8 * k);
#pragma unroll
        for (int j = 0; j < 4; ++j) { o[0][4 * k + j] *= a[j]; o[1][4 * k + j] *= a[j]; } }
    bf16x8 pa[4];
    { u32x4 w;
      w = (u32x4){cvtpk(p0[0], p0[1]), cvtpk(p0[2], p0[3]), cvtpk(p0[4], p0[5]), cvtpk(p0[6], p0[7])}; pa[0] = __builtin_bit_cast(bf16x8, w);
      w = (u32x4){cvtpk(p0[8], p0[9]), cvtpk(p0[10], p0[11]), cvtpk(p0[12], p0[13]), cvtpk(p0[14], p0[15])}; pa[1] = __builtin_bit_cast(bf16x8, w);
      w = (u32x4){cvtpk(p1[0], p1[1]), cvtpk(p1[2], p1[3]), cvtpk(p1[4], p1[5]), cvtpk(p1[6], p1[7])}; pa[2] = __builtin_bit_cast(bf16x8, w);
      w = (u32x4){cvtpk(p1[8], p1[9]), cvtpk(p1[10], p1[11]), cvtpk(p1[12], p1[13]), cvtpk(p1[14], p1[15])}; pa[3] = __builtin_bit_cast(bf16x8, w); }
    const int vb = ((lane >> 4) & 1) * 32 + (lane & 3) * 8 + (4 * hi + ((lane & 15) >> 2)) * 64;
    pv(o, vslot + vb, pa);
}
template <class Mod>
__device__ __forceinline__ void flash_scores(LAS const unsigned char* kslot, const bf16x8 (&qr)[4], f32x16 (&o)[2], float& m, float& l, LAS float* wsf, int lane, const Mod& mod, bf16x8 (&pa)[4]) {
    const int r32 = lane & 31, hi = lane >> 5;
    f32x16 p0, p1; qkt(p0, p1, kslot, qr, r32, hi);
    mod.apply(p0, p1, r32, hi);
    float rm = fmaxf(p0[0], p1[0]);
#pragma unroll
    for (int r = 1; r < 16; ++r) rm = fmaxf(rm, fmaxf(p0[r], p1[r]));
    rm = fmaxf(rm, __shfl_xor(rm, 32));
    const float mn = fmaxf(m, rm); const float alpha = __builtin_amdgcn_exp2f(m - mn); m = mn;
    float s = 0.f;
#pragma unroll
    for (int r = 0; r < 16; ++r) { p0[r] = __builtin_amdgcn_exp2f(p0[r] - mn); p1[r] = __builtin_amdgcn_exp2f(p1[r] - mn); s += p0[r] + p1[r]; }
    l = l * alpha + s;
    { LAS float* ww = wsf + r32; asm volatile("" : "+v"(ww)); if (hi == 0) *ww = alpha; }
    asm volatile("" ::: "memory");
    LAS const float* wr_ = wsf + 4 * hi; asm volatile("" : "+v"(wr_));
#pragma unroll
    for (int k = 0; k < 4; ++k) { const f32x4 a = *(LAS const f32x4*)(wr_ + 8 * k);
#pragma unroll
        for (int j = 0; j < 4; ++j) { o[0][4 * k + j] *= a[j]; o[1][4 * k + j] *= a[j]; } }
    { u32x4 w;
      w = (u32x4){cvtpk(p0[0], p0[1]), cvtpk(p0[2], p0[3]), cvtpk(p0[4], p0[5]), cvtpk(p0[6], p0[7])}; pa[0] = __builtin_bit_cast(bf16x8, w);
      w = (u32x4){cvtpk(p0[8], p0[9]), cvtpk(p0[10], p0[11]), cvtpk(p0[12], p0[13]), cvtpk(p0[14], p0[15])}; pa[1] = __builtin_bit_cast(bf16x8, w);
      w = (u32x4){cvtpk(p1[0], p1[1]), cvtpk(p1[2], p1[3]), cvtpk(p1[4], p1[5]), cvtpk(p1[6], p1[7])}; pa[2] = __builtin_bit_cast(bf16x8, w);
      w = (u32x4){cvtpk(p1[8], p1[9]), cvtpk(p1[10], p1[11]), cvtpk(p1[12], p1[13]), cvtpk(p1[14], p1[15])}; pa[3] = __builtin_bit_cast(bf16x8, w); }
    asm volatile("" : "+v"(pa[0]), "+v"(pa[1]), "+v"(pa[2]), "+v"(pa[3]) :: "memory");
}
__device__ __forceinline__ void pv_lane(f32x16 (&o)[2], LAS const unsigned char* vslot, const bf16x8 (&pa)[4], int lane) {
    const int hi = lane >> 5;
    const int vb = ((lane >> 4) & 1) * 32 + (lane & 3) * 8 + (4 * hi + ((lane & 15) >> 2)) * 64;
    pv(o, vslot + vb, pa);
}
__device__ __forceinline__ float max3f(float a, float b, float c) { float r; asm("v_max3_f32 %0, %1, %2, %3" : "=v"(r) : "v"(a), "v"(b), "v"(c)); return r; }
__device__ __forceinline__ float rowmax32(const f32x16& p0, const f32x16& p1) {
    float a = max3f(p0[0], p0[1], p1[0]), b = max3f(p0[2], p0[3], p1[1]); a = max3f(a, p1[2], p1[3]);
#pragma unroll
    for (int r = 4; r < 16; r += 4) { a = max3f(a, p0[r], p0[r + 1]); b = max3f(b, p0[r + 2], p0[r + 3]); a = max3f(a, p1[r], p1[r + 1]); b = max3f(b, p1[r + 2], p1[r + 3]); }
    return fmaxf(a, b);
}
constexpr float THRL = 8.f;
__device__ __forceinline__ void qkt2(f32x16& p0, f32x16& p1, LAS const unsigned char* kslot, const bf16x8 (&qr)[4], const f32x16& negm, int r32, int hi) {
#pragma unroll
    for (int d0 = 0; d0 < 4; ++d0) {
        LAS const unsigned char* kb = kslot + (2 * d0 + hi) * 1024 + ((r32 ^ (2 * d0 + hi)) * 16); asm volatile("" : "+v"(kb));
        const bf16x8 b0 = *(LAS const bf16x8*)(kb);
        const bf16x8 b1 = *(LAS const bf16x8*)(kb + 512);
        if (d0 == 0) { p0 = __builtin_amdgcn_mfma_f32_32x32x16_bf16(b0, qr[0], negm, 0, 0, 0); p1 = __builtin_amdgcn_mfma_f32_32x32x16_bf16(b1, qr[0], negm, 0, 0, 0); }
        else { p0 = __builtin_amdgcn_mfma_f32_32x32x16_bf16(b0, qr[d0], p0, 0, 0, 0); p1 = __builtin_amdgcn_mfma_f32_32x32x16_bf16(b1, qr[d0], p1, 0, 0, 0); }
    }
}
template <bool HASNEXT, class Mod>
__device__ __forceinline__ void softmax2(f32x16& p0, f32x16& p1, f32x16 (&o)[2], f32x16& negm, float& mref, float& l, LAS float* wsf, int lane, const Mod& mod, bf16x8 (&pa)[4], f32x16& n0, f32x16& n1) {
    const int r32 = lane & 31, hi = lane >> 5;
    mod.apply(p0, p1, r32, hi);
    float rm = rowmax32(p0, p1);
    if (__builtin_expect(__any(rm > THRL), 0)) {
        rm = fmaxf(rm, __shfl_xor(rm, 32));
        const float dl = fmaxf(rm, 0.f);
        mref += dl;
#pragma unroll
        for (int r = 0; r < 16; ++r) { p0[r] -= dl; p1[r] -= dl; }
        if (HASNEXT) {
#pragma unroll
            for (int r = 0; r < 16; ++r) { n0[r] -= dl; n1[r] -= dl; } }
#pragma unroll
        for (int r = 0; r < 16; ++r) negm[r] = -mref;
        const float f = __builtin_amdgcn_exp2f(-dl); l *= f;
        { LAS float* ww = wsf + r32; asm volatile("" : "+v"(ww)); if (hi == 0) *ww = f; }
        asm volatile("" ::: "memory");
        LAS const float* wr_ = wsf + 4 * hi; asm volatile("" : "+v"(wr_));
#pragma unroll
        for (int k = 0; k < 4; ++k) { const f32x4 a = *(LAS const f32x4*)(wr_ + 8 * k);
#pragma unroll
            for (int j = 0; j < 4; ++j) { o[0][4 * k + j] *= a[j]; o[1][4 * k + j] *= a[j]; } }
    }
    float s = 0.f;
#pragma unroll
    for (int r = 0; r < 16; ++r) { p0[r] = __builtin_amdgcn_exp2f(p0[r]); p1[r] = __builtin_amdgcn_exp2f(p1[r]); s += p0[r] + p1[r]; }
    l += s;
    { u32x4 w;
      w = (u32x4){cvtpk(p0[0], p0[1]), cvtpk(p0[2], p0[3]), cvtpk(p0[4], p0[5]), cvtpk(p0[6], p0[7])}; pa[0] = __builtin_bit_cast(bf16x8, w);
      w = (u32x4){cvtpk(p0[8], p0[9]), cvtpk(p0[10], p0[11]), cvtpk(p0[12], p0[13]), cvtpk(p0[14], p0[15])}; pa[1] = __builtin_bit_cast(bf16x8, w);
      w = (u32x4){cvtpk(p1[0], p1[1]), cvtpk(p1[2], p1[3]), cvtpk(p1[4], p1[5]), cvtpk(p1[6], p1[7])}; pa[2] = __builtin_bit_cast(bf16x8, w);
      w = (u32x4){cvtpk(p1[8], p1[9]), cvtpk(p1[10], p1[11]), cvtpk(p1[12], p1[13]), cvtpk(p1[14], p1[15])}; pa[3] = __builtin_bit_cast(bf16x8, w); }
}
__device__ __forceinline__ void flash_finish(f32x16 (&o)[2], float l, LAS float* wsf, LAS unsigned char* stg, bf16_t* Obase, size_t qstride, int lane) {
    asm volatile("" : "+v"(lane));
    const int r32 = lane & 31, hi = lane >> 5;
    l += __shfl_xor(l, 32);
    { LAS float* ww = wsf + 32 + r32; asm volatile("" : "+v"(ww)); if (hi == 0) *ww = l; }
    asm volatile("" ::: "memory");
    LAS const float* wr_ = wsf + 32 + 4 * hi; asm volatile("" : "+v"(wr_));
    LAS bf16_t* st = (LAS bf16_t*)stg + (4 * hi) * 64 + r32; asm volatile("" : "+v"(st));
#pragma unroll
    for (int k = 0; k < 4; ++k) { const f32x4 a = *(LAS const f32x4*)(wr_ + 8 * k);
#pragma unroll
        for (int j = 0; j < 4; ++j) { const float rl = __builtin_amdgcn_rcpf(a[j]);
            st[(j + 8 * k) * 64] = (bf16_t)(cvtpk(o[0][4 * k + j] * rl, 0.f) & 0xffffu);
            st[(j + 8 * k) * 64 + 32] = (bf16_t)(cvtpk(o[1][4 * k + j] * rl, 0.f) & 0xffffu); } }
    asm volatile("" ::: "memory");
    LAS const bf16_t* sr = (LAS const bf16_t*)stg + (lane >> 3) * 64 + (lane & 7) * 8; asm volatile("" : "+v"(sr));
    bf16_t* op = Obase + (size_t)(lane >> 3) * qstride + (lane & 7) * 8;
#pragma unroll
    for (int i = 0; i < 4; ++i) { const u32x4 v = *(LAS const u32x4*)(sr + i * 8 * 64);
        *(u32x4*)(op + (size_t)(i * 8) * qstride) = v; }
}

__device__ __forceinline__ void flash_finish_c(f32x16 (&o)[2], float l, float mref, LAS float* wsf, LAS unsigned char* stg, bf16_t* Obase, size_t qstride, int lane, float* lse0, int lstep, bool merge) {
    asm volatile("" : "+v"(lane));
    const int r32 = lane & 31, hi = lane >> 5;
    float* lsep = lse0 + (size_t)r32 * lstep;
    l += __shfl_xor(l, 32);
    const float lse2 = mref + __builtin_amdgcn_logf(l);
    float fa = 0.f, rl = __builtin_amdgcn_rcpf(l);
    if (merge) { const float lse1 = *lsep; const float M = fmaxf(lse1, lse2); const float w1 = __builtin_amdgcn_exp2f(lse1 - M), w2 = __builtin_amdgcn_exp2f(lse2 - M); const float inv = __builtin_amdgcn_rcpf(w1 + w2); fa = w1 * inv; rl = w2 * inv * rl; }
    else if (hi == 0) *lsep = lse2;
    { LAS float* ww = wsf + r32; asm volatile("" : "+v"(ww)); if (hi == 0) { ww[0] = fa; ww[32] = rl; } }
    asm volatile("" ::: "memory");
    LAS const float* wr_ = wsf + 32 + 4 * hi; asm volatile("" : "+v"(wr_));
    LAS bf16_t* st = (LAS bf16_t*)stg + (4 * hi) * 64 + r32; asm volatile("" : "+v"(st));
#pragma unroll
    for (int k = 0; k < 4; ++k) { const f32x4 a = *(LAS const f32x4*)(wr_ + 8 * k);
#pragma unroll
        for (int j = 0; j < 4; ++j) {
            st[(j + 8 * k) * 64] = (bf16_t)(cvtpk(o[0][4 * k + j] * a[j], 0.f) & 0xffffu);
            st[(j + 8 * k) * 64 + 32] = (bf16_t)(cvtpk(o[1][4 * k + j] * a[j], 0.f) & 0xffffu); } }
    asm volatile("" ::: "memory");
    LAS const bf16_t* sr = (LAS const bf16_t*)stg + (lane >> 3) * 64 + (lane & 7) * 8; asm volatile("" : "+v"(sr));
    LAS const float* fr_ = wsf + (lane >> 3); asm volatile("" : "+v"(fr_));
    bf16_t* op = Obase + (size_t)(lane >> 3) * qstride + (lane & 7) * 8;
#pragma unroll
    for (int i = 0; i < 4; ++i) { u32x4 v = *(LAS const u32x4*)(sr + i * 8 * 64);
        if (merge) { const float f = fr_[i * 8]; const u32x4 g = *(const u32x4*)(op + (size_t)(i * 8) * qstride);
            v.x = cvtpk(__builtin_fmaf(f, __builtin_bit_cast(float, g.x << 16), __builtin_bit_cast(float, v.x << 16)), __builtin_fmaf(f, __builtin_bit_cast(float, g.x & 0xffff0000u), __builtin_bit_cast(float, v.x & 0xffff0000u)));
            v.y = cvtpk(__builtin_fmaf(f, __builtin_bit_cast(float, g.y << 16), __builtin_bit_cast(float, v.y << 16)), __builtin_fmaf(f, __builtin_bit_cast(float, g.y & 0xffff0000u), __builtin_bit_cast(float, v.y & 0xffff0000u)));
            v.z = cvtpk(__builtin_fmaf(f, __builtin_bit_cast(float, g.z << 16), __builtin_bit_cast(float, v.z << 16)), __builtin_fmaf(f, __builtin_bit_cast(float, g.z & 0xffff0000u), __builtin_bit_cast(float, v.z & 0xffff0000u)));
            v.w = cvtpk(__builtin_fmaf(f, __builtin_bit_cast(float, g.w << 16), __builtin_bit_cast(float, v.w << 16)), __builtin_fmaf(f, __builtin_bit_cast(float, g.w & 0xffff0000u), __builtin_bit_cast(float, v.w & 0xffff0000u))); }
        *(u32x4*)(op + (size_t)(i * 8) * qstride) = v; }
}

#define XB_TMO      128
#define XB_XCNT(j)  (256  + 64 * (j))
#define XB_XSUB(j)  (1280 + 64 * (j))
#define XB_XGEN(j)  (2304 + 64 * (j))
#define XB_TOP      3328
#define XB_TOPGEN   3392
#define XCD_BAR_WORDS 3456
#define XB_SPIN_CAP (1u << 22)
__device__ __forceinline__ unsigned xb_ld(unsigned* p)              { return __hip_atomic_load(p, __ATOMIC_RELAXED, __HIP_MEMORY_SCOPE_AGENT); }
__device__ __forceinline__ unsigned xb_add(unsigned* p, unsigned v) { return __hip_atomic_fetch_add(p, v, __ATOMIC_RELAXED, __HIP_MEMORY_SCOPE_AGENT); }
__device__ __forceinline__ unsigned xb_xcc_id() { return (unsigned)__builtin_amdgcn_s_getreg((3 << 11) | 20) & 0xFu; }
#define XB_SPIN(cond, bar) do { unsigned _sp = 0; while (cond) { __builtin_amdgcn_s_sleep(1); \
    if ((++_sp & 255u) == 0u) { if (xb_ld(&(bar)[XB_TMO])) break; if (_sp > XB_SPIN_CAP) { atomicAdd(&(bar)[XB_TMO], 1u); break; } } } } while (0)
struct XcdBarrier { unsigned* bar; unsigned x; volatile LAS unsigned* st; };
__device__ __forceinline__ XcdBarrier xcd_barrier_post(unsigned* bar, volatile LAS unsigned* st) {
    XcdBarrier b; b.bar = bar; b.x = xb_xcc_id(); b.st = st;
    if (threadIdx.x == 0) (void)xb_add(&bar[XB_XCNT(b.x)], 1u);
    return b;
}
__device__ __forceinline__ void xcd_barrier_complete(unsigned* bar, unsigned x, unsigned& nloc, unsigned& nx) {
    const unsigned G = gridDim.x * gridDim.y * gridDim.z;
    unsigned sum, cnt, mine, sp = 0u;
    for (;;) {
        sum = 0u; cnt = 0u; mine = 0u;
#pragma unroll
        for (unsigned j = 0; j < 16; ++j) { const unsigned c = xb_ld(&bar[XB_XCNT(j)]); sum += c; cnt += (c > 0u) ? 1u : 0u; mine = (j == x) ? c : mine; }
        if (sum == G) break;
        __builtin_amdgcn_s_sleep(1);
        if ((++sp & 255u) == 0u) { if (xb_ld(&bar[XB_TMO])) break; if (sp > XB_SPIN_CAP) { atomicAdd(&bar[XB_TMO], 1u); break; } }
    }
    nloc = mine > 0u ? mine : 1u; nx = cnt > 0u ? cnt : 1u;
}
__device__ __forceinline__ void xcd_barrier(const XcdBarrier& b) {
    asm volatile("s_waitcnt vmcnt(0)" ::: "memory");
    __syncthreads();
    if (threadIdx.x == 0) {
        unsigned* bar = b.bar; asm volatile("" : "+s"(bar));
        __builtin_amdgcn_s_waitcnt(0);
        unsigned nloc = b.st[0], nx = b.st[1];
        if (nloc == 0u) { xcd_barrier_complete(bar, b.x, nloc, nx); b.st[0] = nloc; b.st[1] = nx; }
        const unsigned old = xb_add(&bar[XB_XSUB(b.x)], 1u);
        const unsigned gen = old / nloc;
        if (old + 1u == (gen + 1u) * nloc) {
            __builtin_amdgcn_fence(__ATOMIC_RELEASE, "agent");
            asm volatile("s_waitcnt vmcnt(0)" ::: "memory");
            const unsigned og = xb_add(&bar[XB_TOP], 1u);
            const unsigned tg = og / nx;
            if (og + 1u == (tg + 1u) * nx) xb_add(&bar[XB_TOPGEN], 1u);
            else XB_SPIN(xb_ld(&bar[XB_TOPGEN]) == tg, bar);
            __builtin_amdgcn_fence(__ATOMIC_ACQUIRE, "agent");
            xb_add(&bar[XB_XGEN(b.x)], 1u);
            asm volatile("s_waitcnt vmcnt(0)" ::: "memory");
        } else {
            XB_SPIN(xb_ld(&bar[XB_XGEN(b.x)]) == gen, bar);
            __builtin_amdgcn_fence(__ATOMIC_ACQUIRE, "agent");
            asm volatile("s_waitcnt vmcnt(0)" ::: "memory");
        }
    }
    __syncthreads();
}

struct Params { const float* in[14]; float* out; unsigned char* ws; };

__device__ __forceinline__ void transpose_item(const float* W, int K, int N, bf16_t* WT, const float* gain, int mode, LAS float* scr, int item, int lane) {
    const int nblk = N / 32, kb = item / nblk, nb = item % nblk, k0 = 64 * kb, n0 = 32 * nb;
#pragma unroll 8
    for (int i = 0; i < 32; ++i) { const int kk = 2 * i + (lane >> 5); float w = __builtin_nontemporal_load(W + (size_t)(k0 + kk) * N + n0 + (lane & 31)); if (gain) w *= gain[k0 + kk]; scr[kk * 33 + (lane & 31)] = w; }
    int d0 = n0;
    if (mode == 1) { const int j = n0 < DFF ? n0 : n0 - DFF; d0 = 256 * (j >> 7) + (j & 127) + (n0 < DFF ? 0 : 128); }
    const int c = lane & 7;
#pragma unroll
    for (int j = 0; j < 4; ++j) { const int n = (lane >> 3) + 8 * j; const LAS float* s = scr + (8 * c) * 33 + n;
        u32x4 o; o.x = cvtpk(s[0 * 33], s[1 * 33]); o.y = cvtpk(s[2 * 33], s[3 * 33]); o.z = cvtpk(s[4 * 33], s[5 * 33]); o.w = cvtpk(s[6 * 33], s[7 * 33]);
        *(u32x4*)(WT + (size_t)(d0 + n) * K + k0 + 8 * c) = o; }
}

__global__ void __launch_bounds__(NTHREADS) fwd_megakernel(Params P) {
#define GAS __attribute__((address_space(1)))
#define KA(i) ((const float*)(const GAS float*)ka[(i)])
    extern __shared__ __attribute__((aligned(16))) unsigned char lds_raw[];
    cg::grid_group grid = cg::this_grid();
    LAS unsigned char* lds = (LAS unsigned char*)lds_raw;
    const int tid0 = threadIdx.x, wave = __builtin_amdgcn_readfirstlane(tid0 >> 6);
    const int G0 = gridDim.x, bx0 = blockIdx.x;
    const int vcu0 = (G0 % 8 == 0) ? (bx0 % 8) * (G0 / 8) + bx0 / 8 : bx0;
    LAS float* wsf = (LAS float*)(lds + WSF_OFF) + wave * 64;
    volatile LAS unsigned* bst = (volatile LAS unsigned*)(lds + PTAB_OFF);
    if (tid0 < 2) bst[tid0] = 0u;
    __syncthreads();
    XcdBarrier xbar = xcd_barrier_post((unsigned*)(P.ws + WS_BAR), bst);

    for (int ph = 0; ph <= 24; ++ph) {
        const __attribute__((address_space(4))) unsigned long long* ka = (const __attribute__((address_space(4))) unsigned long long*)__builtin_amdgcn_kernarg_segment_ptr(); asm volatile("" : "+s"(ka));
        unsigned char* ws = (unsigned char*)(GAS unsigned char*)ka[15];
        f32x2* rope = (f32x2*)(ws + WS_ROPE);
        float* ssq_all = (float*)(ws + WS_SSQ);
        bf16_t* QKV = (bf16_t*)(ws + WS_QKV); bf16_t* HB = (bf16_t*)(ws + WS_H); bf16_t* OB = (bf16_t*)(ws + WS_O);
        int G = G0, bx = bx0, vcu = vcu0; asm volatile("" : "+s"(G), "+s"(bx), "+s"(vcu));
        const int gw = vcu * NWAVES + wave, NGW = G * NWAVES;
        int tid = tid0; asm volatile("" : "+v"(tid));
        const int lane = tid & 63, r32 = lane & 31, hi = lane >> 5;
        const int c = ph / 12, s = ph % 12;
        const int S = (c == 0) ? 8192 : 4096, nb = RC / S;
        const float* xin = KA(c & 1);
        float* xout = ((float*)(GAS float*)ka[14]) + (size_t)(c & 1) * RC * DM;
        float* ssq = ssq_all + (size_t)(c & 1) * 5 * RC;
        bf16_t* XB = (bf16_t*)(ws + ((c & 1) ? WS_XB1 : WS_XB));
        if (s == 0) {
            if (ph == 0 && (PHM & 1)) {
                LAS float* scr = (LAS float*)(lds + wave * 16384);
                constexpr int I0 = 16 * (NE / 32), I1 = 16 * (DM / 32), I2 = 16 * (NO / 32), I3 = I1, I4 = 16 * (NGU / 32), I5 = I4, I6 = (DFF / 64) * (DM / 32), I7 = I6;
                constexpr int NIT = I0 + I1 + I2 + I3 + I4 + I5 + I6 + I7;
                for (int it = gw; it < NIT; it += NGW) {
                    int r = it;
                    if (r < I0) { transpose_item(KA(5), DM, NE, (bf16_t*)(ws + W_INE), KA(2), 0, scr, r, lane); continue; } r -= I0;
                    if (r < I1) { transpose_item(KA(9), DM, DM, (bf16_t*)(ws + W_OUTE), nullptr, 0, scr, r, lane); continue; } r -= I1;
                    if (r < I2) { transpose_item(KA(10), DM, NO, (bf16_t*)(ws + W_INO), KA(2) + DM, 0, scr, r, lane); continue; } r -= I2;
                    if (r < I3) { transpose_item(KA(11), DM, DM, (bf16_t*)(ws + W_OUTO), nullptr, 0, scr, r, lane); continue; } r -= I3;
                    if (r < I4) { transpose_item(KA(12), DM, NGU, (bf16_t*)(ws + W_GU0), KA(3), 1, scr, r, lane); continue; } r -= I4;
                    if (r < I5) { transpose_item(KA(12) + (size_t)DM * NGU, DM, NGU, (bf16_t*)(ws + W_GU1), KA(3) + DM, 1, scr, r, lane); continue; } r -= I5;
                    if (r < I6) { transpose_item(KA(13), DFF, DM, (bf16_t*)(ws + W_DN0), nullptr, 0, scr, r, lane); continue; } r -= I6;
                    transpose_item(KA(13) + (size_t)DFF * DM, DFF, DM, (bf16_t*)(ws + W_DN1), nullptr, 0, scr, r, lane);
                }
                const int gt = vcu * NTHREADS + tid;
                if (gt < 2048) { const int pos = gt >> 4, i = gt & 15; const float fr = __builtin_amdgcn_exp2f(-(float)i * (13.287712379549449f / 16.f)); const float ang = (float)pos * fr;
                    float sn, cs; sincosf(ang, &sn, &cs); rope[gt] = (f32x2){cs, sn}; }
            }
            if (c >= 1) {
                float* po = ((float*)(GAS float*)ka[14]) + (size_t)(c - 1) * RC * DM; const float* pq = ssq_all + (size_t)(c - 1) * 5 * RC + 4 * RC; const float* gf = KA(4);
                const bf16_t* xp = (const bf16_t*)(ws + (((c - 1) & 1) ? WS_XB1 : WS_XB));
                for (int row = gw; row < RC; row += NGW) { const float rs = __builtin_amdgcn_rsqf(pq[row] * (1.f / DM) + EPS);
#pragma unroll
                    for (int hf = 0; hf < 2; ++hf) { const u32x4 r = __builtin_nontemporal_load((const u32x4*)(xp + (size_t)row * DM + hf * 512 + lane * 8));
                        const f32x4 g0 = *(const f32x4*)(gf + hf * 512 + lane * 8), g1 = *(const f32x4*)(gf + hf * 512 + lane * 8 + 4);
                        f32x4 y0, y1;
                        y0[0] = __builtin_bit_cast(float, r.x << 16); y0[1] = __builtin_bit_cast(float, r.x & 0xffff0000u); y0[2] = __builtin_bit_cast(float, r.y << 16); y0[3] = __builtin_bit_cast(float, r.y & 0xffff0000u);
                        y1[0] = __builtin_bit_cast(float, r.z << 16); y1[1] = __builtin_bit_cast(float, r.z & 0xffff0000u); y1[2] = __builtin_bit_cast(float, r.w << 16); y1[3] = __builtin_bit_cast(float, r.w & 0xffff0000u);
                        f32x4* op = (f32x4*)(po + (size_t)row * DM + hf * 512 + lane * 8);
                        __builtin_nontemporal_store(y0 * rs * g0, op); __builtin_nontemporal_store(y1 * rs * g1, op + 1); } }
            }
            if (c < 2) {
                for (int row = gw; row < RC; row += NGW) { const f32x4* xr = (const f32x4*)(xin + (size_t)row * DM) + lane; f32x4 v[4]; float sq = 0.f;
#pragma unroll
                    for (int j = 0; j < 4; ++j) { v[j] = __builtin_nontemporal_load(xr + 64 * j); sq += (v[j].x * v[j].x + v[j].y * v[j].y) + (v[j].z * v[j].z + v[j].w * v[j].w); }
                    sq = wave_sum(sq); u32x2* o8 = (u32x2*)(XB + (size_t)row * DM) + lane;
#pragma unroll
                    for (int j = 0; j < 4; ++j) o8[64 * j] = (u32x2){cvtpk(v[j].x, v[j].y), cvtpk(v[j].z, v[j].w)};
                    if (lane < 5) ssq[(size_t)lane * RC + row] = lane == 0 ? sq : 0.f; }
            }
        } else if ((s == 1 || s == 7) && (PHM & 2)) {
            const int N = (s == 1) ? NE : NO;
            pg8::Gemm g{XB, (const bf16_t*)(ws + (s == 1 ? W_INE : W_INO)), RC, N, DM}; pg8::StaticOrder SO; SO.init(RC, N, G, bx);
            pg8::EpiScaleBf16 E{QKV, (s == 1) ? NEP : NOP, ssq + (s == 1 ? 0 : 2) * (size_t)RC, (s == 1) ? 3 : 0, (s == 1) ? 5 : 4, C2};
            for (int rep = 0; rep < ((DUP & 4) ? 2 : 1); ++rep) pg8::gemm_phase<pg8::EpiScaleBf16>(lds, g, SO, E, wave);
        } else if ((s == 4 || s == 6 || s == 9 || s == 11) && (PHM & 4)) {
            const bool dn = (s == 6 || s == 11); const int K = dn ? DFF : DM;
            const size_t woff = (s == 4) ? W_OUTE : (s == 6) ? W_DN0 : (s == 9) ? W_OUTO : W_DN1;
            pg8::Gemm g{dn ? HB : OB, (const bf16_t*)(ws + woff), RC, DM, K}; pg8::StaticOrder SO; SO.init(RC, DM, G, bx);
            const int qi = (s == 4) ? 1 : (s == 6) ? 2 : (s == 9) ? 3 : 4;
            pg8::EpiResidual E{XB, ssq + (size_t)qi * RC};
            pg8::gemm_phase<pg8::EpiResidual>(lds, g, SO, E, wave);
        } else if ((s == 5 || s == 10) && (PHM & 8)) {
            pg8::Gemm g{XB, (const bf16_t*)(ws + (s == 5 ? W_GU0 : W_GU1)), RC, NGU, DM}; pg8::StaticOrder SO; SO.init(RC, NGU, G, bx);
            pg8::EpiSwiGLU E{HB, ssq + (size_t)(s == 5 ? 1 : 3) * RC};
            for (int rep = 0; rep < ((DUP & 4) ? 2 : 1); ++rep) pg8::gemm_phase<pg8::EpiSwiGLU>(lds, g, SO, E, wave);
        } else if (s == 2 && (PHM & 16)) {
            const float* gq = KA(6); const float* gk = KA(7);
            for (int row = gw; row < RC; row += NGW) { const int t = row & (S - 1), pr = t >> 6, pc = t & 63;
#pragma unroll
                for (int pass = 0; pass < 2; ++pass) { const int hh0 = (lane >> 3) + 8 * pass; const bool act = hh0 < 10; const int hh = act ? hh0 : 9; const int cc = lane & 7;
                    bf16_t* ptr = QKV + (size_t)row * NEP + hh * 64 + cc * 8; const u32x4 raw = *(const u32x4*)ptr; const float* gn = (hh < 8 ? gq : gk) + cc * 8;
                    float y[8]; y[0] = bf2f(raw.x & 0xffff); y[1] = bf2f(raw.x >> 16); y[2] = bf2f(raw.y & 0xffff); y[3] = bf2f(raw.y >> 16); y[4] = bf2f(raw.z & 0xffff); y[5] = bf2f(raw.z >> 16); y[6] = bf2f(raw.w & 0xffff); y[7] = bf2f(raw.w >> 16);
                    float sq = 0.f;
#pragma unroll
                    for (int j = 0; j < 8; ++j) sq += y[j] * y[j];
                    sq += __shfl_xor(sq, 1); sq += __shfl_xor(sq, 2); sq += __shfl_xor(sq, 4);
                    const float rn = __builtin_amdgcn_rsqf(sq * (1.f / 64.f) + EPS);
                    const int pos = (cc >> 2) ? pc : pr; const f32x2* tb = rope + pos * 16 + (cc & 1) * 8; const bool first = (cc & 3) < 2; const float sc = hh < 8 ? C2 : 1.f;
                    float ov[8];
#pragma unroll
                    for (int j = 0; j < 8; ++j) { const float yy = y[j] * rn * gn[j]; const float py = __shfl_xor(yy, 2); const f32x2 cs = tb[j];
                        ov[j] = (first ? (yy * cs.x - py * cs.y) : (py * cs.y + yy * cs.x)) * sc; }
                    if (act) *(u32x4*)ptr = (u32x4){cvtpk(ov[0], ov[1]), cvtpk(ov[2], ov[3]), cvtpk(ov[4], ov[5]), cvtpk(ov[6], ov[7])}; } }
            { LAS float* tabL = (LAS float*)(lds + RPB_OFF); const float* rpb = KA(8);
              for (int i = tid; i < 3720; i += NTHREADS) tabL[i] = rpb[i] * LOG2E;
              __syncthreads();
              const int rows = S >> 6; const int ntask = nb * rows * 16;
              LAS unsigned char* wl = lds + wave * 16384;
              for (int rep = 0; rep < ((DUP & 2) ? 2 : 1); ++rep)
              for (int wt = gw; wt < ntask; wt += NGW) {
                  const int qh = wt & 1, h = (wt >> 1) & 7, br = wt >> 4, r = br % rows, b = br / rows;
                  const int rs0 = min(max(r - 4, 0), rows - 8);
                  const size_t rowbase = (size_t)b * S;
                  const int qc = qh * 32 + r32, cs = min(max(qc - 8, 0), 48);
                  const bf16_t* qp = QKV + (rowbase + r * 64 + qc) * NEP + 768 + h * 64 + hi * 8;
                  bf16x8 qr[4];
#pragma unroll
                  for (int d0 = 0; d0 < 4; ++d0) qr[d0] = *(const bf16x8*)(qp + d0 * 16);
                  f32x16 o[2]; o[0] = (f32x16){}; o[1] = (f32x16){}; f32x16 negm = (f32x16){}; float mref = 0.f, l = 0.f;
                  const int lrow = lane >> 3, ch = lane & 7;
                  const int lrowV = 2 * (lane >> 4) + ((lane >> 2) & 1), dhV = (lane >> 3) & 1, cwV = lane & 3;
                  const bf16_t* kp = QKV + (rowbase + (size_t)rs0 * 64 + lrow) * NEP + 1280 + h * 64 + ch * 8;
                  const bf16_t* vp = QKV + (rowbase + (size_t)rs0 * 64 + lrowV) * NEP + 1792 + h * 64 + dhV * 32 + cwV * 8;
                  u32x4 kr[8], vr[8];
#pragma unroll
                  for (int j = 0; j < 8; ++j) { kr[j] = *(const u32x4*)(kp + (size_t)(8 * j) * NEP); vr[j] = *(const u32x4*)(vp + (size_t)(8 * j) * NEP); }
                  const int kcs = 4 * hi - cs;
                  for (int jt = 0; jt < 8; ++jt) {
                      LAS unsigned char* kw = wl + ch * 1024 + (lrow ^ ch) * 16; LAS unsigned char* vw = wl + 8192 + dhV * 4096 + lrowV * 64 + cwV * 16; asm volatile("" : "+v"(kw), "+v"(vw));
#pragma unroll
                      for (int j = 0; j < 8; ++j) { *(LAS u32x4*)(kw + j * 128) = kr[j]; *(LAS u32x4*)(vw + j * 512) = vr[j]; }
                      int kcs_ = kcs; asm volatile("" : "+v"(kcs_));
                      ModNA mod{kcs_, tabL + (h * 15 + (rs0 + jt - r + 7)) * 31 + (15 - qc + 4 * hi)};
                      bf16x8 pa[4];
                      if (jt + 1 < 8) { const bf16_t* kn = kp + (size_t)(jt + 1) * 64 * NEP; const bf16_t* vn = vp + (size_t)(jt + 1) * 64 * NEP;
#pragma unroll
                          for (int j = 0; j < 8; ++j) { kr[j] = *(const u32x4*)(kn + (size_t)(8 * j) * NEP); vr[j] = *(const u32x4*)(vn + (size_t)(8 * j) * NEP); } }
                      f32x16 s0, s1;
                      qkt2(s0, s1, wl, qr, negm, r32, hi);
                      softmax2<false>(s0, s1, o, negm, mref, l, wsf, lane, mod, pa, s0, s1);
                      pv_lane(o, wl + 8192, pa, lane);
                      asm volatile("" ::: "memory");
                  }
                  flash_finish(o, l, wsf, wl, OB + (rowbase + r * 64 + qh * 32) * DM + 512 + h * 64, DM, lane);
              } }
        } else if (s == 3 && (PHM & 32)) {
            const int nqb = S >> 8, ntask = nb * 8 * nqb, NT = S >> 6;
            LAS unsigned char* stg = lds + 81920 + wave * 4096;
            float gqm = 0.f, gkm = 0.f;
            { const float* gq = KA(6); const float* gk = KA(7);
              for (int i = 0; i < 64; ++i) { gqm = fmaxf(gqm, __builtin_fabsf(gq[i])); gkm = fmaxf(gkm, __builtin_fabsf(gk[i])); } }
            const float sbound = 64.f * C2 * gqm * gkm * 1.001f;
            const bool fastA = sbound < 64.f;
            for (int rep = 0; rep < ((DUP & 1) ? 2 : 1); ++rep)
            for (int task = vcu; task < ntask; task += G) {
                const int qb = task % nqb, bh = task / nqb, h = bh & 7, b = bh >> 3;
                const size_t rowbase = (size_t)b * S;
                const int q0 = qb * 256 + wave * 32;
                const bf16_t* qp = QKV + (rowbase + q0 + r32) * NEP + h * 64 + hi * 8;
                bf16x8 qr[4];
#pragma unroll
                for (int d0 = 0; d0 < 4; ++d0) qr[d0] = *(const bf16x8*)(qp + d0 * 16);
                f32x16 o[2]; o[0] = (f32x16){}; o[1] = (f32x16){}; float l = 0.f;
                const int trow = wave * 8 + (lane >> 3), ch = lane & 7;
                const int trowV = wave * 8 + 2 * (lane >> 4) + ((lane >> 2) & 1), dhV = (lane >> 3) & 1, cwV = lane & 3;
                const bf16_t* kp = QKV + (rowbase + trow) * NEP + 512 + (h >> 2) * 64 + ch * 8;
                const bf16_t* vp = QKV + (rowbase + trowV) * NEP + 640 + (h >> 2) * 64 + dhV * 32 + cwV * 8;
                const unsigned kdst = ch * 1024 + (trow ^ ch) * 16, vdst = 8192 + dhV * 4096 + trowV * 64 + cwV * 16;
                u32x4 kreg = *(const u32x4*)kp, vreg = *(const u32x4*)vp;
                if (!fastA) {
                    float m = -1e30f;
                    *(LAS u32x4*)(lds + kdst) = kreg; *(LAS u32x4*)(lds + vdst) = vreg;
                    __syncthreads();
                    for (int t = 0; t < NT; ++t) {
                        const unsigned cur = (t & 1) * 16384u, nxt = 16384u - cur;
                        if (t + 1 < NT) { kreg = *(const u32x4*)(kp + (size_t)(t + 1) * 64 * NEP); vreg = *(const u32x4*)(vp + (size_t)(t + 1) * 64 * NEP); }
                        flash_step(lds + cur, lds + cur + 8192, qr, o, m, l, wsf, lane, ModNone{});
                        if (t + 1 < NT) { *(LAS u32x4*)(lds + nxt + kdst) = kreg; *(LAS u32x4*)(lds + nxt + vdst) = vreg; }
                        __syncthreads();
                    }
                    flash_finish(o, l, wsf, stg, OB + (rowbase + q0) * DM + h * 64, DM, lane);
                    continue;
                }
                u32x4 kreg1 = *(const u32x4*)(kp + (size_t)64 * NEP), vreg1 = *(const u32x4*)(vp + (size_t)64 * NEP);
                u32x4 kreg2 = *(const u32x4*)(kp + (size_t)128 * NEP), vreg2 = *(const u32x4*)(vp + (size_t)128 * NEP);
                *(LAS u32x4*)(lds + kdst) = kreg; *(LAS u32x4*)(lds + vdst) = vreg;
                *(LAS u32x4*)(lds + 16384 + kdst) = kreg1; *(LAS u32x4*)(lds + 16384 + vdst) = vreg1;
                *(LAS u32x4*)(lds + 32768 + kdst) = kreg2; *(LAS u32x4*)(lds + 32768 + vdst) = vreg2;
                __syncthreads();
                f32x16 sa0, sa1, sb0, sb1;
                { const f32x16 z_ = (f32x16){}; qkt2(sa0, sa1, lds, qr, z_, r32, hi); }
                unsigned bcur = 0, bnxt = 16384, bnn = 49152;
                const int vbl = ((lane >> 4) & 1) * 32 + (lane & 3) * 8 + (4 * hi + ((lane & 15) >> 2)) * 64;
#define A_SCHED __builtin_amdgcn_sched_barrier(0)
#define A_STEP(C0, C1, N0, N1, T_) do { \
                    if ((T_) + 3 < NT) { kreg = *(const u32x4*)(kp + (size_t)((T_) + 3) * 64 * NEP); vreg = *(const u32x4*)(vp + (size_t)((T_) + 3) * 64 * NEP); } \
                    bf16x8 kf[4], kg[4]; \
                    { _Pragma("unroll") for (int d0 = 0; d0 < 2; ++d0) { LAS const unsigned char* kb_ = lds + bnxt + (2 * d0 + hi) * 1024 + ((r32 ^ (2 * d0 + hi)) * 16); asm volatile("" : "+v"(kb_)); \
                        kf[2 * d0] = *(LAS const bf16x8*)(kb_); kf[2 * d0 + 1] = *(LAS const bf16x8*)(kb_ + 512); } } \
                    A_SCHED; \
                    { _Pragma("unroll") for (int d0 = 2; d0 < 4; ++d0) { LAS const unsigned char* kb_ = lds + bnxt + (2 * d0 + hi) * 1024 + ((r32 ^ (2 * d0 + hi)) * 16); asm volatile("" : "+v"(kb_)); \
                        kg[2 * d0 - 4] = *(LAS const bf16x8*)(kb_); kg[2 * d0 - 3] = *(LAS const bf16x8*)(kb_ + 512); } } \
                    N0 = __builtin_amdgcn_mfma_f32_32x32x16_bf16(kf[0], qr[0], (f32x16){}, 0, 0, 0); N1 = __builtin_amdgcn_mfma_f32_32x32x16_bf16(kf[1], qr[0], (f32x16){}, 0, 0, 0); \
                    N0 = __builtin_amdgcn_mfma_f32_32x32x16_bf16(kf[2], qr[1], N0, 0, 0, 0);   N1 = __builtin_amdgcn_mfma_f32_32x32x16_bf16(kf[3], qr[1], N1, 0, 0, 0); \
                    A_SCHED; \
                    N0 = __builtin_amdgcn_mfma_f32_32x32x16_bf16(kg[0], qr[2], N0, 0, 0, 0);   N1 = __builtin_amdgcn_mfma_f32_32x32x16_bf16(kg[1], qr[2], N1, 0, 0, 0); \
                    N0 = __builtin_amdgcn_mfma_f32_32x32x16_bf16(kg[2], qr[3], N0, 0, 0, 0);   N1 = __builtin_amdgcn_mfma_f32_32x32x16_bf16(kg[3], qr[3], N1, 0, 0, 0); \
                    A_SCHED; \
                    s16x4 vlo[4], vhi[4]; \
                    { LAS const unsigned char* vp_ = lds + bcur + 8192 + vbl; asm volatile("" : "+v"(vp_)); \
                      _Pragma("unroll") for (int i = 0; i < 4; ++i) { vlo[i] = vtr(vp_ + (i & 3) * 1024); vhi[i] = vtr(vp_ + (i & 3) * 1024 + 512); } } \
                    A_SCHED; \
                    float s_ = 0.f; \
                    _Pragma("unroll") for (int r = 0; r < 16; ++r) { C0[r] = __builtin_amdgcn_exp2f(C0[r]); C1[r] = __builtin_amdgcn_exp2f(C1[r]); s_ += C0[r] + C1[r]; } \
                    l += s_; \
                    bf16x8 pa[4]; \
                    { u32x4 w; \
                      w = (u32x4){cvtpk(C0[0], C0[1]), cvtpk(C0[2], C0[3]), cvtpk(C0[4], C0[5]), cvtpk(C0[6], C0[7])}; pa[0] = __builtin_bit_cast(bf16x8, w); \
                      w = (u32x4){cvtpk(C0[8], C0[9]), cvtpk(C0[10], C0[11]), cvtpk(C0[12], C0[13]), cvtpk(C0[14], C0[15])}; pa[1] = __builtin_bit_cast(bf16x8, w); \
                      w = (u32x4){cvtpk(C1[0], C1[1]), cvtpk(C1[2], C1[3]), cvtpk(C1[4], C1[5]), cvtpk(C1[6], C1[7])}; pa[2] = __builtin_bit_cast(bf16x8, w); \
                      w = (u32x4){cvtpk(C1[8], C1[9]), cvtpk(C1[10], C1[11]), cvtpk(C1[12], C1[13]), cvtpk(C1[14], C1[15])}; pa[3] = __builtin_bit_cast(bf16x8, w); } \
                    A_SCHED; \
                    _Pragma("unroll") for (int i = 0; i < 4; ++i) { const bf16x8 vf = (bf16x8){vlo[i][0], vlo[i][1], vlo[i][2], vlo[i][3], vhi[i][0], vhi[i][1], vhi[i][2], vhi[i][3]}; \
                        o[0] = __builtin_amdgcn_mfma_f32_32x32x16_bf16(pa[i], vf, o[0], 0, 0, 0); } \
                    A_SCHED; \
                    { LAS const unsigned char* vp_ = lds + bcur + 8192 + 4096 + vbl; asm volatile("" : "+v"(vp_)); \
                      _Pragma("unroll") for (int i = 0; i < 4; ++i) { vlo[i] = vtr(vp_ + i * 1024); vhi[i] = vtr(vp_ + i * 1024 + 512); } } \
                    if ((T_) + 3 < NT) { *(LAS u32x4*)(lds + bnn + kdst) = kreg; *(LAS u32x4*)(lds + bnn + vdst) = vreg; } \
                    A_SCHED; \
                    _Pragma("unroll") for (int i = 0; i < 4; ++i) { const bf16x8 vf = (bf16x8){vlo[i][0], vlo[i][1], vlo[i][2], vlo[i][3], vhi[i][0], vhi[i][1], vhi[i][2], vhi[i][3]}; \
                        o[1] = __builtin_amdgcn_mfma_f32_32x32x16_bf16(pa[i], vf, o[1], 0, 0, 0); } \
                    if (BAR_) __syncthreads(); \
                    bcur = bnxt; bnxt = (bnxt == 65536u) ? 0u : bnxt + 16384u; bnn = (bnn == 65536u) ? 0u : bnn + 16384u; \
                } while (0)
                for (int t = 0; t < NT; t += 2) {
#define BAR_ false
                    A_STEP(sa0, sa1, sb0, sb1, t);
#undef BAR_
#define BAR_ true
                    A_STEP(sb0, sb1, sa0, sa1, t + 1);
#undef BAR_
                }
#undef A_STEP
#undef A_SCHED
                flash_finish(o, l, wsf, stg, OB + (rowbase + q0) * DM + h * 64, DM, lane);
            }
        } else if (s == 8 && (PHM & 64)) {
            const int nib = S >> 9, nqb = S >> 5;
            LAS unsigned char* wl = lds + wave * 16384;
            float* LSE = (float*)(ws + WS_LSE);
            for (int pass = 0; pass < 2; ++pass) {
            const int ntask = pass == 0 ? nb * 16 * nqb : nb * 16 * nib * 16;
            const int qstep = pass == 0 ? 1 : 16, ubeg = pass == 0 ? 0 : 10, uend = pass == 0 ? 3 : 17;
            for (int wt = gw; wt < ntask; wt += NGW) {
                int tmin, h, b;
                if (pass == 0) { const int qb = wt % nqb, bh = wt / nqb; h = bh & 15; b = bh >> 4; tmin = qb * 32; }
                else { const int rho = wt & 15, ib = (wt >> 4) % nib, bh = (wt >> 4) / nib; h = bh & 15; b = bh >> 4; tmin = rho + 512 * ib; }
                const size_t rowbase = (size_t)b * S;
                const int tq = tmin + qstep * r32;
                const float slope2 = __builtin_amdgcn_exp2f(-0.5f * (float)(h + 1)) * LOG2E;
                const bf16_t* qp = QKV + (rowbase + tq) * NOP + h * 64 + hi * 8;
                bf16x8 qr[4];
#pragma unroll
                for (int d0 = 0; d0 < 4; ++d0) qr[d0] = *(const bf16x8*)(qp + d0 * 16);
                f32x16 o[2]; o[0] = (f32x16){}; o[1] = (f32x16){}; f32x16 negm = (f32x16){}; float mref = 0.f, l = 0.f;
                const int lrow = lane >> 3, ch = lane & 7;
                const int lrowV = 2 * (lane >> 4) + ((lane >> 2) & 1), dhV = (lane >> 3) & 1, cwV = lane & 3;
                const bf16_t* kb = QKV + rowbase * NOP + 1024 + h * 64 + ch * 8;
                const bf16_t* vb = QKV + rowbase * NOP + 2048 + h * 64 + dhV * 32 + cwV * 8;
                u32x4 kr[8], vr[8];
#define DIL_TILE(u, SH, T0) do { const int g_ = (u) < 10 ? 0 : ((u) < 14 ? 1 : 2); SH = 2 * g_; const int tt_ = (u) - (g_ == 0 ? 0 : (g_ == 1 ? 10 : 14)); T0 = tmin - (64 << SH) + ((64 * tt_) << SH); } while (0)
#define DIL_LOADK(SH, T0) do { int lr_ = lrow; asm volatile("" : "+v"(lr_)); _Pragma("unroll") for (int j = 0; j < 8; ++j) { const int tk_ = min(max(T0 + ((lr_ + 8 * j) << SH), 0), S - 1); kr[j] = *(const u32x4*)(kb + (size_t)tk_ * NOP); } } while (0)
#define DIL_LOADV(SH, T0) do { int lr_ = lrowV; asm volatile("" : "+v"(lr_)); _Pragma("unroll") for (int j = 0; j < 8; ++j) { const int tv_ = min(max(T0 + ((lr_ + 8 * j) << SH), 0), S - 1); vr[j] = *(const u32x4*)(vb + (size_t)tv_ * NOP); } } while (0)
                int sh, t0; DIL_TILE(ubeg, sh, t0); DIL_LOADK(sh, t0); DIL_LOADV(sh, t0);
                for (int u = ubeg; u < uend; ++u) {
                    LAS unsigned char* kw = wl + ch * 1024 + (lrow ^ ch) * 16; LAS unsigned char* vw = wl + 8192 + dhV * 4096 + lrowV * 64 + cwV * 16; asm volatile("" : "+v"(kw), "+v"(vw));
#pragma unroll
                    for (int j = 0; j < 8; ++j) { *(LAS u32x4*)(kw + j * 128) = kr[j]; *(LAS u32x4*)(vw + j * 512) = vr[j]; }
                    int tq_ = tq; asm volatile("" : "+v"(tq_));
                    ModDil mod{(float)(tq_ - t0 - ((4 * hi) << sh)), (float)(1 << sh), (float)(64 << sh), slope2, (float)tq_, (float)(tq_ - S), (t0 >= 0) && (t0 + (63 << sh) < S)};
                    bf16x8 pa[4];
                    if (u + 1 < uend) { DIL_TILE(u + 1, sh, t0); DIL_LOADK(sh, t0); }
                    f32x16 s0, s1;
                    qkt2(s0, s1, wl, qr, negm, r32, hi);
                    softmax2<false>(s0, s1, o, negm, mref, l, wsf, lane, mod, pa, s0, s1);
                    asm volatile("" ::: "memory");
                    if (u + 1 < uend) { DIL_LOADV(sh, t0); }
                    pv_lane(o, wl + 8192, pa, lane);
                    asm volatile("" ::: "memory");
                }
#undef DIL_TILE
#undef DIL_LOADK
#undef DIL_LOADV
                flash_finish_c(o, l, mref, wsf, wl, OB + (rowbase + tmin) * DM + h * 64, (size_t)qstep * DM, lane, LSE + (rowbase + tmin) * 16 + h, qstep * 16, pass == 1);
            }
            if (pass == 0) xcd_barrier(xbar);
            }
        }
        if (ph == 0) grid.sync(); else if (ph < 24) xcd_barrier(xbar);
    }
}

#undef KA
extern "C" void kernel_launch(void* const* d_in, const int* in_sizes, int n_in, void* d_out, int out_size, void* d_ws, size_t ws_size, hipStream_t stream) {
    static int grid_blocks = 0;
    if (!grid_blocks) {
        int dev = 0, cus = 0, per_cu = 0;
        hipGetDevice(&dev);
        hipDeviceGetAttribute(&cus, hipDeviceAttributeMultiprocessorCount, dev);
        hipFuncSetAttribute((const void*)fwd_megakernel, hipFuncAttributeMaxDynamicSharedMemorySize, LDS_BYTES);
        hipOccupancyMaxActiveBlocksPerMultiprocessor(&per_cu, (const void*)fwd_megakernel, NTHREADS, LDS_BYTES);
        if (per_cu < 1) per_cu = 1;
        grid_blocks = cus * per_cu;
        if (n_in != 14 || ws_size < WS_END) fprintf(stderr, "kernel_launch: unexpected n_in %d / ws_size %zu\n", n_in, ws_size);
    }
    (void)hipMemsetAsync((char*)d_ws + WS_BAR, 0, 16384, stream);
    Params p{};
    for (int i = 0; i < 14; ++i) p.in[i] = (const float*)d_in[i];
    p.out = (float*)d_out; p.ws = (unsigned char*)d_ws;
    void* args[] = {&p};
    hipError_t e = hipLaunchCooperativeKernel((const void*)fwd_megakernel, dim3(grid_blocks), dim3(NTHREADS), args, LDS_BYTES, stream);
    if (e != hipSuccess) fprintf(stderr, "cooperative launch failed: %s (grid %d)\n", hipGetErrorString(e), grid_blocks);
}
```

```cpp
#include <hip/hip_runtime.h>
#include <hip/hip_cooperative_groups.h>
#include <cstdio>
#include <cstdint>
namespace cg = cooperative_groups;

#define LAS __attribute__((address_space(3)))
typedef unsigned short bf16_t;
typedef short bf16x8 __attribute__((ext_vector_type(8)));
typedef short s16x4 __attribute__((ext_vector_type(4)));
typedef float f32x2 __attribute__((ext_vector_type(2)));
typedef float f32x4 __attribute__((ext_vector_type(4)));
typedef float f32x16 __attribute__((ext_vector_type(16)));
typedef unsigned u32x2 __attribute__((ext_vector_type(2)));
typedef unsigned u32x4 __attribute__((ext_vector_type(4)));
typedef __bf16 bf16x2_t __attribute__((ext_vector_type(2)));

constexpr int DM = 1024, DFF = 2816, RC = 65536;
constexpr int NE = 2304, NO = 3072, NGU = 5632;
constexpr int NEP = NE + 64, NOP = NO + 64;
constexpr float EPS = 1e-6f, LOG2E = 1.4426950408889634f, C2 = 0.125f * 1.4426950408889634f;
constexpr int NTHREADS = 512, NWAVES = 8;
#ifndef PHM
#define PHM 127
#endif
#ifndef DUP
#define DUP 0
#endif

constexpr size_t MiB = 1u << 20;
constexpr size_t WS_ROPE = 0;
constexpr size_t WS_BAR = 65536;
constexpr size_t WS_SSQ = 1 * MiB;
constexpr size_t WS_W = 4 * MiB;
constexpr size_t W_INE = WS_W, W_OUTE = W_INE + (size_t)NE * DM * 2, W_INO = W_OUTE + (size_t)DM * DM * 2, W_OUTO = W_INO + (size_t)NO * DM * 2;
constexpr size_t W_GU0 = W_OUTO + (size_t)DM * DM * 2, W_GU1 = W_GU0 + (size_t)NGU * DM * 2, W_DN0 = W_GU1 + (size_t)NGU * DM * 2, W_DN1 = W_DN0 + (size_t)DM * DFF * 2;
constexpr size_t W_END = W_DN1 + (size_t)DM * DFF * 2;
constexpr size_t WS_XB = 52 * MiB;
constexpr size_t WS_QKV = 180 * MiB;
constexpr size_t WS_H = 180 * MiB;
constexpr size_t WS_O = 576 * MiB;
constexpr size_t WS_XB1 = 704 * MiB;
constexpr size_t WS_LSE = 832 * MiB;
constexpr size_t WS_END = 836 * MiB;
static_assert(W_END <= WS_XB, "weights fit");
static_assert(WS_QKV + (size_t)RC * NOP * 2 <= WS_O && WS_H + (size_t)RC * DFF * 2 <= WS_O, "qkv/h fit");

constexpr int RING_BYTES = 131072;
constexpr int WSF_OFF = RING_BYTES;
constexpr int RPB_OFF = WSF_OFF + 2048;
constexpr int PTAB_OFF = 148736;
constexpr int LDS_BYTES = 151552;
static_assert(RPB_OFF + 3720 * 4 + 512 <= PTAB_OFF && PTAB_OFF + 128 <= LDS_BYTES, "lds map");
__device__ __forceinline__ const float* ldptr(LAS const unsigned long long* tab, int i) {
    const unsigned long long v = tab[i];
    const unsigned lo = __builtin_amdgcn_readfirstlane((unsigned)v), hi = __builtin_amdgcn_readfirstlane((unsigned)(v >> 32));
    return (const float*)(((unsigned long long)hi << 32) | lo);
}

__device__ __forceinline__ unsigned cvtpk(float lo, float hi) { f32x2 v = {lo, hi}; bf16x2_t b = __builtin_convertvector(v, bf16x2_t); return __builtin_bit_cast(unsigned, b); }
__device__ __forceinline__ float bf2f(unsigned short h) { return __builtin_bit_cast(float, (unsigned)h << 16); }
__device__ __forceinline__ float wave_sum(float v) {
#pragma unroll
    for (int o = 1; o < 64; o <<= 1) v += __shfl_xor(v, o);
    return v;
}

namespace pg8 {
constexpr int BM = 256, BK = 64, HALF = 128, HTB = HALF * BK * 2, STAGE_BYTES = 8 * HTB, NXCD = 8, WGM = 8;
__host__ __device__ __forceinline__ int lds_byte(int r, int c) { const int st = (r >> 4) * 2 + (c >> 5), rr = r & 15, cc = c & 31, ob = rr * 64 + cc * 2; return st * 1024 + (ob ^ (((ob >> 9) & 1) << 5)); }
__host__ __device__ __forceinline__ void stage_rc(int b, int& R, int& C) { const int st = b / 1024, sb = b % 1024, swz = sb ^ (((sb >> 9) & 1) << 5); R = (st >> 1) * 16 + swz / 64; C = (st & 1) * 32 + (swz % 64) / 2; }
__host__ __device__ __forceinline__ int perm32(int rho) { const int n = rho >> 4, i = rho & 15; return 8 * (i >> 2) + 4 * n + (i & 3); }
struct Unit { int pm, pn; };
struct Gemm { const bf16_t* A; const bf16_t* Bt; int M, N, K; };
struct StaticOrder {
    int nM, nN, nwg, G, c;
    __host__ __device__ void init(int M, int N, int G_, int c_) { nM = M / BM; nN = N / BM; nwg = nM * nN; G = G_; c = c_; }
    __host__ __device__ bool next(int i, Unit& u) const {
        const long L = (long)i * G + c; if (L >= nwg) return false;
        int wgid = (int)L; { const int q = nwg / NXCD, r = nwg % NXCD, xcd = wgid % NXCD, off = wgid / NXCD; wgid = (xcd < r ? xcd * (q + 1) : r * (q + 1) + (xcd - r) * q) + off; }
        const int nig = WGM * nN, gid = wgid / nig, fm = gid * WGM, gsz = (nM - fm) < WGM ? (nM - fm) : WGM;
        u.pm = fm + ((wgid % nig) % gsz); u.pn = (wgid % nig) / gsz; return true;
    }
};

struct EpiScaleBf16 {
    static constexpr bool PERM = true;
    bf16_t* O; int ldc; const float* ssq; int t0, t1; float tscale;
    __device__ __forceinline__ void pre(const Unit& u, int wr, int fr, float (&pv)[8]) const {
        const int row0 = u.pm * BM + wr * 64 + fr;
#pragma unroll
        for (int i = 0; i < 8; ++i) pv[i] = ssq[row0 + (i >> 2) * HALF + (i & 3) * 16];
    }
    __device__ __forceinline__ void operator()(const f32x4 (&acc)[2][2][4][2], const Unit& u, int wr, int wc, int fr, int fq, const float (&pv)[8]) const {
        const int row0 = u.pm * BM + wr * 64 + fr, col0 = u.pn * BM + wc * 32 + 8 * fq;
        const float sc = (u.pn >= t0 && u.pn < t1) ? tscale : 1.f;
#pragma unroll
        for (int ai = 0; ai < 2; ++ai)
#pragma unroll
            for (int m = 0; m < 4; ++m) { const int row = row0 + ai * HALF + m * 16; const float rs = __builtin_amdgcn_rsqf(pv[ai * 4 + m] * (1.f / DM) + EPS) * sc;
                bf16_t* rowp = O + (size_t)row * ldc + col0;
#pragma unroll
                for (int bj = 0; bj < 2; ++bj) { const f32x4 v0 = acc[ai][bj][m][0] * rs, v1 = acc[ai][bj][m][1] * rs;
                    u32x4 w; w.x = cvtpk(v0[0], v0[1]); w.y = cvtpk(v0[2], v0[3]); w.z = cvtpk(v1[0], v1[1]); w.w = cvtpk(v1[2], v1[3]);
                    *(u32x4*)(rowp + bj * HALF) = w; } }
    }
};
struct EpiSwiGLU {
    static constexpr bool PERM = true;
    bf16_t* H; const float* ssq;
    __device__ __forceinline__ void pre(const Unit& u, int wr, int fr, float (&pv)[8]) const {
        const int row0 = u.pm * BM + wr * 64 + fr;
#pragma unroll
        for (int i = 0; i < 8; ++i) pv[i] = ssq[row0 + (i >> 2) * HALF + (i & 3) * 16];
    }
    __device__ __forceinline__ void operator()(const f32x4 (&acc)[2][2][4][2], const Unit& u, int wr, int wc, int fr, int fq, const float (&pv)[8]) const {
        const int row0 = u.pm * BM + wr * 64 + fr, col0 = u.pn * HALF + wc * 32 + 8 * fq;
#pragma unroll
        for (int ai = 0; ai < 2; ++ai)
#pragma unroll
            for (int m = 0; m < 4; ++m) { const int row = row0 + ai * HALF + m * 16; const float rs = __builtin_amdgcn_rsqf(pv[ai * 4 + m] * (1.f / DM) + EPS);
                float hv[8];
#pragma unroll
                for (int n = 0; n < 2; ++n)
#pragma unroll
                    for (int j = 0; j < 4; ++j) { const float g = acc[ai][0][m][n][j] * rs, uu = acc[ai][1][m][n][j] * rs;
                        const float e = __builtin_amdgcn_exp2f(-g * LOG2E); hv[n * 4 + j] = g * uu * __builtin_amdgcn_rcpf(1.f + e); }
                u32x4 w; w.x = cvtpk(hv[0], hv[1]); w.y = cvtpk(hv[2], hv[3]); w.z = cvtpk(hv[4], hv[5]); w.w = cvtpk(hv[6], hv[7]);
                *(u32x4*)(H + (size_t)row * DFF + col0) = w; }
    }
};
struct EpiResidual {
    static constexpr bool PERM = true;
    bf16_t* xb; float* ssq;
    __device__ __forceinline__ void pre(const Unit&, int, int, float (&)[8]) const {}
    __device__ __forceinline__ void operator()(const f32x4 (&acc)[2][2][4][2], const Unit& u, int wr, int wc, int fr, int fq, const float (&)[8]) const {
        const int row0 = u.pm * BM + wr * 64 + fr, col0 = u.pn * BM + wc * 32 + 8 * fq;
#pragma unroll
        for (int ai = 0; ai < 2; ++ai)
#pragma unroll
            for (int m = 0; m < 4; ++m) { const int row = row0 + ai * HALF + m * 16; bf16_t* rowp = xb + (size_t)row * DM + col0; float s = 0.f;
                u32x4 raw[2];
#pragma unroll
                for (int bj = 0; bj < 2; ++bj) raw[bj] = *(const u32x4*)(rowp + bj * HALF);
#pragma unroll
                for (int bj = 0; bj < 2; ++bj) { const f32x4 a0 = acc[ai][bj][m][0], a1 = acc[ai][bj][m][1]; const u32x4 r = raw[bj];
                    const float x0 = __builtin_bit_cast(float, r.x << 16) + a0[0], x1 = __builtin_bit_cast(float, r.x & 0xffff0000u) + a0[1];
                    const float x2 = __builtin_bit_cast(float, r.y << 16) + a0[2], x3 = __builtin_bit_cast(float, r.y & 0xffff0000u) + a0[3];
                    const float x4 = __builtin_bit_cast(float, r.z << 16) + a1[0], x5 = __builtin_bit_cast(float, r.z & 0xffff0000u) + a1[1];
                    const float x6 = __builtin_bit_cast(float, r.w << 16) + a1[2], x7 = __builtin_bit_cast(float, r.w & 0xffff0000u) + a1[3];
                    u32x4 w; w.x = cvtpk(x0, x1); w.y = cvtpk(x2, x3); w.z = cvtpk(x4, x5); w.w = cvtpk(x6, x7);
                    *(u32x4*)(rowp + bj * HALF) = w;
                    s += ((x0 * x0 + x1 * x1) + (x2 * x2 + x3 * x3)) + ((x4 * x4 + x5 * x5) + (x6 * x6 + x7 * x7)); }
                s += __shfl_xor(s, 16); s += __shfl_xor(s, 32);
                if (fq == 0) atomicAdd(ssq + row, s); }
    }
};

template <class Epi>
__device__ __forceinline__ void gemm_phase(LAS unsigned char* lds, const Gemm g, const StaticOrder& S, const Epi& E, const int wave_id) {
    int tid = threadIdx.x; asm volatile("" : "+v"(tid));
    const int wid = __builtin_amdgcn_readfirstlane(tid >> 6), lane = tid & 63, wr = wid >> 2, wc = wid & 3, fr = lane & 15, fq = lane >> 4;
    const int K = g.K, nt = K / BK;
    unsigned voffA[2], voffB[2];
#pragma unroll
    for (int i = 0; i < 2; ++i) { int R, C; stage_rc(tid * 16 + i * 8192, R, C); const int Rb = Epi::PERM ? ((R & ~31) + perm32(R & 31)) : R;
        voffA[i] = (unsigned)(R * K + C) * 2u; voffB[i] = (unsigned)(Rb * K + C) * 2u; }
    const size_t kstep = (size_t)(BK * 2);
    const size_t hstep = (size_t)HALF * K * 2;
    const size_t tstep = 2 * hstep;
    const unsigned ldsw = (unsigned)wid * 1024u;
    const int aoff = lds_byte(wr * 64 + fr, fq * 8), boff = lds_byte(wc * 32 + fr, fq * 8);
#define PG8_SA(b, h) (((b) * 2 + (h)) * HTB)
#define PG8_SB(b, h) ((4 + (b) * 2 + (h)) * HTB)
#define PG8_STAGE(bufoff, gbase, voff) do { _Pragma("unroll") for (int _i = 0; _i < 2; ++_i) \
        __builtin_amdgcn_global_load_lds((const unsigned*)((const char*)(gbase) + (voff)[_i]), (LAS unsigned*)(lds + (bufoff) + ldsw + _i * 8192), 16, 0, 0); } while (0)
#define PG8_LDA(dst, b, h) do { _Pragma("unroll") for (int m = 0; m < 4; ++m) _Pragma("unroll") for (int k = 0; k < 2; ++k) dst[m][k] = *(const LAS bf16x8*)(lds + PG8_SA(b, h) + aoff + m * 2048 + k * 1024); } while (0)
#define PG8_LDB(dst, b, h) do { _Pragma("unroll") for (int n = 0; n < 2; ++n) _Pragma("unroll") for (int k = 0; k < 2; ++k) dst[n][k] = *(const LAS bf16x8*)(lds + PG8_SB(b, h) + boff + n * 2048 + k * 1024); } while (0)
#define PG8_MMA(ai, bj, At, Bt) do { __builtin_amdgcn_s_setprio(1); _Pragma("unroll") for (int m = 0; m < 4; ++m) _Pragma("unroll") for (int n = 0; n < 2; ++n) _Pragma("unroll") for (int k = 0; k < 2; ++k) \
        acc[ai][bj][m][n] = __builtin_amdgcn_mfma_f32_16x16x32_bf16(Bt[n][k], At[m][k], acc[ai][bj][m][n], 0, 0, 0); __builtin_amdgcn_s_setprio(0); } while (0)
#define PG8_WAIT_V(n) asm volatile("s_waitcnt vmcnt(" #n ")" ::: "memory")
#define PG8_WAIT_L(n) asm volatile("s_waitcnt lgkmcnt(" #n ")" ::: "memory")
#define PG8_BAR __builtin_amdgcn_s_barrier()
#define PG8_SCHED __builtin_amdgcn_sched_barrier(0)
    Unit cur, nxt; int ui = 0;
    if (!S.next(0, cur)) return;
    f32x4 acc[2][2][4][2];
#pragma unroll
    for (int a = 0; a < 2; ++a)
#pragma unroll
        for (int b = 0; b < 2; ++b)
#pragma unroll
            for (int m = 0; m < 4; ++m)
#pragma unroll
                for (int n = 0; n < 2; ++n) acc[a][b][m][n] = (f32x4){0.f, 0.f, 0.f, 0.f};
    bf16x8 At[4][2], B0[2][2], B1[2][2];
    float epre[8] = {0.f, 0.f, 0.f, 0.f, 0.f, 0.f, 0.f, 0.f};
    const char* cA = (const char*)g.A + (size_t)cur.pm * tstep; const char* cB = (const char*)g.Bt + (size_t)cur.pn * tstep;
    PG8_STAGE(PG8_SB(0, 0), cB, voffB); PG8_STAGE(PG8_SB(0, 1), cB + hstep, voffB); PG8_STAGE(PG8_SA(0, 0), cA, voffA); PG8_STAGE(PG8_SA(0, 1), cA + hstep, voffA);
    if (wr == 1) PG8_BAR;
    PG8_WAIT_V(2); PG8_BAR;
    PG8_STAGE(PG8_SB(1, 0), cB + kstep, voffB); PG8_STAGE(PG8_SA(1, 0), cA + kstep, voffA); PG8_STAGE(PG8_SB(1, 1), cB + hstep + kstep, voffB);
    PG8_WAIT_V(6); PG8_BAR;
    for (;;) {
        const bool has_next = S.next(ui + 1, nxt);
        const char* nA = has_next ? (const char*)g.A + (size_t)nxt.pm * tstep : cA; const char* nB = has_next ? (const char*)g.Bt + (size_t)nxt.pn * tstep : cB;
        for (int t = 0; t < nt; t += 2) {
            const bool last = (t == nt - 2);
            if (last) E.pre(cur, wr, fr, epre);
            const char* a1 = cA + (size_t)(t + 1) * kstep;
            const char* a2 = last ? nA : cA + (size_t)(t + 2) * kstep; const char* b2 = last ? nB : cB + (size_t)(t + 2) * kstep;
            const char* a3 = a2 + kstep; const char* b3 = b2 + kstep;
            PG8_LDB(B0, 0, 0); PG8_LDB(B1, 0, 1); PG8_SCHED; PG8_LDA(At, 0, 0); PG8_STAGE(PG8_SA(1, 1), a1 + hstep, voffA);
            PG8_WAIT_V(8); PG8_WAIT_L(0); PG8_BAR; PG8_MMA(0, 0, At, B0); PG8_MMA(0, 1, At, B1); PG8_BAR; PG8_SCHED;
            PG8_LDA(At, 0, 1); PG8_STAGE(PG8_SB(0, 0), b2, voffB); PG8_STAGE(PG8_SB(0, 1), b2 + hstep, voffB); PG8_STAGE(PG8_SA(0, 0), a2, voffA);
            PG8_WAIT_V(8); PG8_WAIT_L(0); PG8_BAR; PG8_MMA(1, 0, At, B0); PG8_MMA(1, 1, At, B1); PG8_BAR; PG8_SCHED;
            PG8_LDB(B0, 1, 0); PG8_LDB(B1, 1, 1); PG8_SCHED; PG8_LDA(At, 1, 0); PG8_STAGE(PG8_SA(0, 1), a2 + hstep, voffA);
            PG8_WAIT_V(8); PG8_WAIT_L(0); PG8_BAR; PG8_MMA(0, 0, At, B0); PG8_MMA(0, 1, At, B1); PG8_BAR; PG8_SCHED;
            PG8_LDA(At, 1, 1); PG8_STAGE(PG8_SB(1, 0), b3, voffB); PG8_STAGE(PG8_SB(1, 1), b3 + hstep, voffB); PG8_STAGE(PG8_SA(1, 0), a3, voffA);
            PG8_WAIT_V(8); PG8_WAIT_L(0); PG8_BAR; PG8_MMA(1, 0, At, B0); PG8_MMA(1, 1, At, B1); PG8_BAR; PG8_SCHED;
        }
        if (wr == 0) PG8_BAR;
        E(acc, cur, wr, wc, fr, fq, epre);
        if (!has_next) break;
#pragma unroll
        for (int a = 0; a < 2; ++a)
#pragma unroll
            for (int b = 0; b < 2; ++b)
#pragma unroll
                for (int m = 0; m < 4; ++m)
#pragma unroll
                    for (int n = 0; n < 2; ++n) acc[a][b][m][n] = (f32x4){0.f, 0.f, 0.f, 0.f};
        cur = nxt; cA = nA; cB = nB; ++ui;
        if (wr == 1) PG8_BAR;
    }
    PG8_WAIT_V(0);
    PG8_BAR;
#undef PG8_SA
#undef PG8_SB
#undef PG8_STAGE
#undef PG8_LDA
#undef PG8_LDB
#undef PG8_MMA
#undef PG8_WAIT_V
#undef PG8_WAIT_L
#undef PG8_BAR
#undef PG8_SCHED
}
}

__device__ __forceinline__ void qkt(f32x16& p0, f32x16& p1, LAS const unsigned char* kslot, const bf16x8 (&qr)[4], int r32, int hi) {
    p0 = (f32x16){}; p1 = (f32x16){};
#pragma unroll
    for (int d0 = 0; d0 < 4; ++d0) {
        LAS const unsigned char* kb = kslot + (2 * d0 + hi) * 1024 + ((r32 ^ (2 * d0 + hi)) * 16); asm volatile("" : "+v"(kb));
        const bf16x8 b0 = *(LAS const bf16x8*)(kb);
        const bf16x8 b1 = *(LAS const bf16x8*)(kb + 512);
        p0 = __builtin_amdgcn_mfma_f32_32x32x16_bf16(b0, qr[d0], p0, 0, 0, 0);
        p1 = __builtin_amdgcn_mfma_f32_32x32x16_bf16(b1, qr[d0], p1, 0, 0, 0);
    }
}
__device__ __forceinline__ s16x4 vtr(LAS const unsigned char* p) { return __builtin_bit_cast(s16x4, __builtin_amdgcn_ds_read_tr16_b64_v4i16((LAS s16x4*)p)); }
__device__ __forceinline__ void pv(f32x16 (&o)[2], LAS const unsigned char* vp, const bf16x8 (&pa)[4]) {
    asm volatile("" : "+v"(vp));
#pragma unroll
    for (int d0 = 0; d0 < 2; ++d0)
#pragma unroll
        for (int ks = 0; ks < 4; ++ks) {
            const s16x4 lo = vtr(vp + d0 * 4096 + ks * 1024), hh = vtr(vp + d0 * 4096 + ks * 1024 + 512);
            const bf16x8 vf = (bf16x8){lo[0], lo[1], lo[2], lo[3], hh[0], hh[1], hh[2], hh[3]};
            o[d0] = __builtin_amdgcn_mfma_f32_32x32x16_bf16(pa[ks], vf, o[d0], 0, 0, 0);
        }
}
struct ModNone { __device__ __forceinline__ void apply(f32x16&, f32x16&, int, int) const {} };
struct ModNA {
    int kcs; LAS const float* tl;
    __device__ __forceinline__ void apply(f32x16& p0, f32x16& p1, int, int) const {
#pragma unroll
        for (int r = 0; r < 16; ++r) { constexpr int dummy = 0; (void)dummy; const int cr = (r & 3) + 8 * (r >> 2);
            { const float v = p0[r] + tl[cr]; p0[r] = ((unsigned)(cr + kcs) < 16u) ? v : -INFINITY; }
            { const float v = p1[r] + tl[cr + 32]; p1[r] = ((unsigned)(cr + 32 + kcs) < 16u) ? v : -INFINITY; } }
    }
};
struct ModNAP {
    int kcs; LAS const float* tl; int U[8], C8[8];
    __device__ __forceinline__ void apply(f32x16& p0, f32x16& p1, int, int) const {
#pragma unroll
        for (int r = 0; r < 16; ++r) { const int gq = r >> 2, w = r & 3;
            { const float v = p0[r] + tl[U[gq] + w]; p0[r] = ((unsigned)(C8[gq] + w + kcs) < 16u) ? v : -INFINITY; }
            { const float v = p1[r] + tl[U[gq + 4] + w]; p1[r] = ((unsigned)(C8[gq + 4] + w + kcs) < 16u) ? v : -INFINITY; } }
    }
};
struct ModDil {
    float af, strf, limf, slope2, tqf, tqmS; bool inb;
    __device__ __forceinline__ void apply(f32x16& p0, f32x16& p1, int, int) const {
        if (inb) {
#pragma unroll
            for (int r = 0; r < 16; ++r) { const float cr = (float)((r & 3) + 8 * (r >> 2));
                { const float d = __builtin_fmaf(-cr, strf, af); const float v = __builtin_fmaf(-slope2, __builtin_fabsf(d), p0[r]); p0[r] = (__builtin_fabsf(d) <= limf) ? v : -INFINITY; }
                { const float d = __builtin_fmaf(-(cr + 32.f), strf, af); const float v = __builtin_fmaf(-slope2, __builtin_fabsf(d), p1[r]); p1[r] = (__builtin_fabsf(d) <= limf) ? v : -INFINITY; } }
        } else {
#pragma unroll
            for (int r = 0; r < 16; ++r) { const float cr = (float)((r & 3) + 8 * (r >> 2));
                { const float d = __builtin_fmaf(-cr, strf, af); const float v = __builtin_fmaf(-slope2, __builtin_fabsf(d), p0[r]); p0[r] = ((__builtin_fabsf(d) <= limf) && (d <= tqf) && (d > tqmS)) ? v : -INFINITY; }
                { const float d = __builtin_fmaf(-(cr + 32.f), strf, af); const float v = __builtin_fmaf(-slope2, __builtin_fabsf(d), p1[r]); p1[r] = ((__builtin_fabsf(d) <= limf) && (d <= tqf) && (d > tqmS)) ? v : -INFINITY; } }
        }
    }
};
template <class Mod>
__device__ __forceinline__ void flash_step(LAS const unsigned char* kslot, LAS const unsigned char* vslot, const bf16x8 (&qr)[4], f32x16 (&o)[2], float& m, float& l, LAS float* wsf, int lane, const Mod& mod) {
    const int r32 = lane & 31, hi = lane >> 5;
    f32x16 p0, p1; qkt(p0, p1, kslot, qr, r32, hi);
    mod.apply(p0, p1, r32, hi);
    float rm = fmaxf(p0[0], p1[0]);
#pragma unroll
    for (int r = 1; r < 16; ++r) rm = fmaxf(rm, fmaxf(p0[r], p1[r]));
    rm = fmaxf(rm, __shfl_xor(rm, 32));
    const float mn = fmaxf(m, rm); const float alpha = __builtin_amdgcn_exp2f(m - mn); m = mn;
    float s = 0.f;
#pragma unroll
    for (int r = 0; r < 16; ++r) { p0[r] = __builtin_amdgcn_exp2f(p0[r] - mn); p1[r] = __builtin_amdgcn_exp2f(p1[r] - mn); s += p0[r] + p1[r]; }
    l = l * alpha + s;
    { LAS float* ww = wsf + r32; asm volatile("" : "+v"(ww)); if (hi == 0) *ww = alpha; }
    asm volatile("" ::: "memory");
    LAS const float* wr_ = wsf + 4 * hi; asm volatile("" : "+v"(wr_));
#pragma unroll
    for (int k = 0; k < 4; ++k) { const f32x4 a = *(LAS const f32x4*)(wr_ + 8 * k);
#pragma unroll
        for (int j = 0; j < 4; ++j) { o[0][4 * k + j] *= a[j]; o[1][4 * k + j] *= a[j]; } }
    bf16x8 pa[4];
    { u32x4 w;
      w = (u32x4){cvtpk(p0[0], p0[1]), cvtpk(p0[2], p0[3]), cvtpk(p0[4], p0[5]), cvtpk(p0[6], p0[7])}; pa[0] = __builtin_bit_cast(bf16x8, w);
      w = (u32x4){cvtpk(p0[8], p0[9]), cvtpk(p0[10], p0[11]), cvtpk(p0[12], p0[13]), cvtpk(p0[14], p0[15])}; pa[1] = __builtin_bit_cast(bf16x8, w);
      w = (u32x4){cvtpk(p1[0], p1[1]), cvtpk(p1[2], p1[3]), cvtpk(p1[4], p1[5]), cvtpk(p1[6], p1[7])}; pa[2] = __builtin_bit_cast(bf16x8, w);
      w = (u32x4){cvtpk(p1[8], p1[9]), cvtpk(p1[10], p1[11]), cvtpk(p1[12], p1[13]), cvtpk(p1[14], p1[15])}; pa[3] = __builtin_bit_cast(bf16x8, w); }
    const int vb = ((lane >> 4) & 1) * 32 + (lane & 3) * 8 + (4 * hi + ((lane & 15) >> 2)) * 64;
    pv(o, vslot + vb, pa);
}
template <class Mod>
__device__ __forceinline__ void flash_scores(LAS const unsigned char* kslot, const bf16x8 (&qr)[4], f32x16 (&o)[2], float& m, float& l, LAS float* wsf, int lane, const Mod& mod, bf16x8 (&pa)[4]) {
    const int r32 = lane & 31, hi = lane >> 5;
    f32x16 p0, p1; qkt(p0, p1, kslot, qr, r32, hi);
    mod.apply(p0, p1, r32, hi);
    float rm = fmaxf(p0[0], p1[0]);
#pragma unroll
    for (int r = 1; r < 16; ++r) rm = fmaxf(rm, fmaxf(p0[r], p1[r]));
    rm = fmaxf(rm, __shfl_xor(rm, 32));
    const float mn = fmaxf(m, rm); const float alpha = __builtin_amdgcn_exp2f(m - mn); m = mn;
    float s = 0.f;
#pragma unroll
    for (int r = 0; r < 16; ++r) { p0[r] = __builtin_amdgcn_exp2f(p0[r] - mn); p1[r] = __builtin_amdgcn_exp2f(p1[r] - mn); s += p0[r] + p1[r]; }
    l = l * alpha + s;
    { LAS float* ww = wsf + r32; asm volatile("" : "+v"(ww)); if (hi == 0) *ww = alpha; }
    asm volatile("" ::: "memory");
    LAS const float* wr_ = wsf + 4 * hi; asm volatile("" : "+v"(wr_));
#pragma unroll
    for (int k = 0; k < 4; ++k) { const f32x4 a = *(LAS const f32x4*)(wr_ + 8 * k);
#pragma unroll
        for (int j = 0; j < 4; ++j) { o[0][4 * k + j] *= a[j]; o[1][4 * k + j] *= a[j]; } }
    { u32x4 w;
      w = (u32x4){cvtpk(p0[0], p0[1]), cvtpk(p0[2], p0[3]), cvtpk(p0[4], p0[5]), cvtpk(p0[6], p0[7])}; pa[0] = __builtin_bit_cast(bf16x8, w);
      w = (u32x4){cvtpk(p0[8], p0[9]), cvtpk(p0[10], p0[11]), cvtpk(p0[12], p0[13]), cvtpk(p0[14], p0[15])}; pa[1] = __builtin_bit_cast(bf16x8, w);
      w = (u32x4){cvtpk(p1[0], p1[1]), cvtpk(p1[2], p1[3]), cvtpk(p1[4], p1[5]), cvtpk(p1[6], p1[7])}; pa[2] = __builtin_bit_cast(bf16x8, w);
      w = (u32x4){cvtpk(p1[8], p1[9]), cvtpk(p1[10], p1[11]), cvtpk(p1[12], p1[13]), cvtpk(p1[14], p1[15])}; pa[3] = __builtin_bit_cast(bf16x8, w); }
    asm volatile("" : "+v"(pa[0]), "+v"(pa[1]), "+v"(pa[2]), "+v"(pa[3]) :: "memory");
}
__device__ __forceinline__ void pv_lane(f32x16 (&o)[2], LAS const unsigned char* vslot, const bf16x8 (&pa)[4], int lane) {
    const int hi = lane >> 5;
    const int vb = ((lane >> 4) & 1) * 32 + (lane & 3) * 8 + (4 * hi + ((lane & 15) >> 2)) * 64;
    pv(o, vslot + vb, pa);
}
__device__ __forceinline__ float max3f(float a, float b, float c) { float r; asm("v_max3_f32 %0, %1, %2, %3" : "=v"(r) : "v"(a), "v"(b), "v"(c)); return r; }
__device__ __forceinline__ float rowmax32(const f32x16& p0, const f32x16& p1) {
    float a = max3f(p0[0], p0[1], p1[0]), b = max3f(p0[2], p0[3], p1[1]); a = max3f(a, p1[2], p1[3]);
#pragma unroll
    for (int r = 4; r < 16; r += 4) { a = max3f(a, p0[r], p0[r + 1]); b = max3f(b, p0[r + 2], p0[r + 3]); a = max3f(a, p1[r], p1[r + 1]); b = max3f(b, p1[r + 2], p1[r + 3]); }
    return fmaxf(a, b);
}
constexpr float THRL = 8.f;
__device__ __forceinline__ void qkt2(f32x16& p0, f32x16& p1, LAS const unsigned char* kslot, const bf16x8 (&qr)[4], const f32x16& negm, int r32, int hi) {
#pragma unroll
    for (int d0 = 0; d0 < 4; ++d0) {
        LAS const unsigned char* kb = kslot + (2 * d0 + hi) * 1024 + ((r32 ^ (2 * d0 + hi)) * 16); asm volatile("" : "+v"(kb));
        const bf16x8 b0 = *(LAS const bf16x8*)(kb);
        const bf16x8 b1 = *(LAS const bf16x8*)(kb + 512);
        if (d0 == 0) { p0 = __builtin_amdgcn_mfma_f32_32x32x16_bf16(b0, qr[0], negm, 0, 0, 0); p1 = __builtin_amdgcn_mfma_f32_32x32x16_bf16(b1, qr[0], negm, 0, 0, 0); }
        else { p0 = __builtin_amdgcn_mfma_f32_32x32x16_bf16(b0, qr[d0], p0, 0, 0, 0); p1 = __builtin_amdgcn_mfma_f32_32x32x16_bf16(b1, qr[d0], p1, 0, 0, 0); }
    }
}
template <bool HASNEXT, class Mod>
__device__ __forceinline__ void softmax2(f32x16& p0, f32x16& p1, f32x16 (&o)[2], f32x16& negm, float& mref, float& l, LAS float* wsf, int lane, const Mod& mod, bf16x8 (&pa)[4], f32x16& n0, f32x16& n1) {
    const int r32 = lane & 31, hi = lane >> 5;
    mod.apply(p0, p1, r32, hi);
    float rm = rowmax32(p0, p1);
    if (__builtin_expect(__any(rm > THRL), 0)) {
        rm = fmaxf(rm, __shfl_xor(rm, 32));
        const float dl = fmaxf(rm, 0.f);
        mref += dl;
#pragma unroll
        for (int r = 0; r < 16; ++r) { p0[r] -= dl; p1[r] -= dl; }
        if (HASNEXT) {
#pragma unroll
            for (int r = 0; r < 16; ++r) { n0[r] -= dl; n1[r] -= dl; } }
#pragma unroll
        for (int r = 0; r < 16; ++r) negm[r] = -mref;
        const float f = __builtin_amdgcn_exp2f(-dl); l *= f;
        { LAS float* ww = wsf + r32; asm volatile("" : "+v"(ww)); if (hi == 0) *ww = f; }
        asm volatile("" ::: "memory");
        LAS const float* wr_ = wsf + 4 * hi; asm volatile("" : "+v"(wr_));
#pragma unroll
        for (int k = 0; k < 4; ++k) { const f32x4 a = *(LAS const f32x4*)(wr_ + 8 * k);
#pragma unroll
            for (int j = 0; j < 4; ++j) { o[0][4 * k + j] *= a[j]; o[1][4 * k + j] *= a[j]; } }
    }
    float s = 0.f;
#pragma unroll
    for (int r = 0; r < 16; ++r) { p0[r] = __builtin_amdgcn_exp2f(p0[r]); p1[r] = __builtin_amdgcn_exp2f(p1[r]); s += p0[r] + p1[r]; }
    l += s;
    { u32x4 w;
      w = (u32x4){cvtpk(p0[0], p0[1]), cvtpk(p0[2], p0[3]), cvtpk(p0[4], p0[5]), cvtpk(p0[6], p0[7])}; pa[0] = __builtin_bit_cast(bf16x8, w);
      w = (u32x4){cvtpk(p0[8], p0[9]), cvtpk(p0[10], p0[11]), cvtpk(p0[12], p0[13]), cvtpk(p0[14], p0[15])}; pa[1] = __builtin_bit_cast(bf16x8, w);
      w = (u32x4){cvtpk(p1[0], p1[1]), cvtpk(p1[2], p1[3]), cvtpk(p1[4], p1[5]), cvtpk(p1[6], p1[7])}; pa[2] = __builtin_bit_cast(bf16x8, w);
      w = (u32x4){cvtpk(p1[8], p1[9]), cvtpk(p1[10], p1[11]), cvtpk(p1[12], p1[13]), cvtpk(p1[14], p1[15])}; pa[3] = __builtin_bit_cast(bf16x8, w); }
}
__device__ __forceinline__ void flash_finish(f32x16 (&o)[2], float l, LAS float* wsf, LAS unsigned char* stg, bf16_t* Obase, size_t qstride, int lane) {
    asm volatile("" : "+v"(lane));
    const int r32 = lane & 31, hi = lane >> 5;
    l += __shfl_xor(l, 32);
    { LAS float* ww = wsf + 32 + r32; asm volatile("" : "+v"(ww)); if (hi == 0) *ww = l; }
    asm volatile("" ::: "memory");
    LAS const float* wr_ = wsf + 32 + 4 * hi; asm volatile("" : "+v"(wr_));
    LAS bf16_t* st = (LAS bf16_t*)stg + (4 * hi) * 64 + r32; asm volatile("" : "+v"(st));
#pragma unroll
    for (int k = 0; k < 4; ++k) { const f32x4 a = *(LAS const f32x4*)(wr_ + 8 * k);
#pragma unroll
        for (int j = 0; j < 4; ++j) { const float rl = __builtin_amdgcn_rcpf(a[j]);
            st[(j + 8 * k) * 64] = (bf16_t)(cvtpk(o[0][4 * k + j] * rl, 0.f) & 0xffffu);
            st[(j + 8 * k) * 64 + 32] = (bf16_t)(cvtpk(o[1][4 * k + j] * rl, 0.f) & 0xffffu); } }
    asm volatile("" ::: "memory");
    LAS const bf16_t* sr = (LAS const bf16_t*)stg + (lane >> 3) * 64 + (lane & 7) * 8; asm volatile("" : "+v"(sr));
    bf16_t* op = Obase + (size_t)(lane >> 3) * qstride + (lane & 7) * 8;
#pragma unroll
    for (int i = 0; i < 4; ++i) { const u32x4 v = *(LAS const u32x4*)(sr + i * 8 * 64);
        *(u32x4*)(op + (size_t)(i * 8) * qstride) = v; }
}

__device__ __forceinline__ void flash_finish_c(f32x16 (&o)[2], float l, float mref, LAS float* wsf, LAS unsigned char* stg, bf16_t* Obase, size_t qstride, int lane, float* lse0, int lstep, bool merge) {
    asm volatile("" : "+v"(lane));
    const int r32 = lane & 31, hi = lane >> 5;
    float* lsep = lse0 + (size_t)r32 * lstep;
    l += __shfl_xor(l, 32);
    const float lse2 = mref + __builtin_amdgcn_logf(l);
    float fa = 0.f, rl = __builtin_amdgcn_rcpf(l);
    if (merge) { const float lse1 = *lsep; const float M = fmaxf(lse1, lse2); const float w1 = __builtin_amdgcn_exp2f(lse1 - M), w2 = __builtin_amdgcn_exp2f(lse2 - M); const float inv = __builtin_amdgcn_rcpf(w1 + w2); fa = w1 * inv; rl = w2 * inv * rl; }
    else if (hi == 0) *lsep = lse2;
    { LAS float* ww = wsf + r32; asm volatile("" : "+v"(ww)); if (hi == 0) { ww[0] = fa; ww[32] = rl; } }
    asm volatile("" ::: "memory");
    LAS const float* wr_ = wsf + 32 + 4 * hi; asm volatile("" : "+v"(wr_));
    LAS bf16_t* st = (LAS bf16_t*)stg + (4 * hi) * 64 + r32; asm volatile("" : "+v"(st));
#pragma unroll
    for (int k = 0; k < 4; ++k) { const f32x4 a = *(LAS const f32x4*)(wr_ + 8 * k);
#pragma unroll
        for (int j = 0; j < 4; ++j) {
            st[(j + 8 * k) * 64] = (bf16_t)(cvtpk(o[0][4 * k + j] * a[j], 0.f) & 0xffffu);
            st[(j + 8 * k) * 64 + 32] = (bf16_t)(cvtpk(o[1][4 * k + j] * a[j], 0.f) & 0xffffu); } }
    asm volatile("" ::: "memory");
    LAS const bf16_t* sr = (LAS const bf16_t*)stg + (lane >> 3) * 64 + (lane & 7) * 8; asm volatile("" : "+v"(sr));
    LAS const float* fr_ = wsf + (lane >> 3); asm volatile("" : "+v"(fr_));
    bf16_t* op = Obase + (size_t)(lane >> 3) * qstride + (lane & 7) * 8;
#pragma unroll
    for (int i = 0; i < 4; ++i) { u32x4 v = *(LAS const u32x4*)(sr + i * 8 * 64);
        if (merge) { const float f = fr_[i * 8]; const u32x4 g = *(const u32x4*)(op + (size_t)(i * 8) * qstride);
            v.x = cvtpk(__builtin_fmaf(f, __builtin_bit_cast(float, g.x << 16), __builtin_bit_cast(float, v.x << 16)), __builtin_fmaf(f, __builtin_bit_cast(float, g.x & 0xffff0000u), __builtin_bit_cast(float, v.x & 0xffff0000u)));
            v.y = cvtpk(__builtin_fmaf(f, __builtin_bit_cast(float, g.y << 16), __builtin_bit_cast(float, v.y << 16)), __builtin_fmaf(f, __builtin_bit_cast(float, g.y & 0xffff0000u), __builtin_bit_cast(float, v.y & 0xffff0000u)));
            v.z = cvtpk(__builtin_fmaf(f, __builtin_bit_cast(float, g.z << 16), __builtin_bit_cast(float, v.z << 16)), __builtin_fmaf(f, __builtin_bit_cast(float, g.z & 0xffff0000u), __builtin_bit_cast(float, v.z & 0xffff0000u)));
            v.w = cvtpk(__builtin_fmaf(f, __builtin_bit_cast(float, g.w << 16), __builtin_bit_cast(float, v.w << 16)), __builtin_fmaf(f, __builtin_bit_cast(float, g.w & 0xffff0000u), __builtin_bit_cast(float, v.w & 0xffff0000u))); }
        *(u32x4*)(op + (size_t)(i * 8) * qstride) = v; }
}

#define XB_TMO      128
#define XB_XCNT(j)  (256  + 64 * (j))
#define XB_XSUB(j)  (1280 + 64 * (j))
#define XB_XGEN(j)  (2304 + 64 * (j))
#define XB_TOP      3328
#define XB_TOPGEN   3392
#define XCD_BAR_WORDS 3456
#define XB_SPIN_CAP (1u << 22)
__device__ __forceinline__ unsigned xb_ld(unsigned* p)              { return __hip_atomic_load(p, __ATOMIC_RELAXED, __HIP_MEMORY_SCOPE_AGENT); }
__device__ __forceinline__ unsigned xb_add(unsigned* p, unsigned v) { return __hip_atomic_fetch_add(p, v, __ATOMIC_RELAXED, __HIP_MEMORY_SCOPE_AGENT); }
__device__ __forceinline__ unsigned xb_xcc_id() { return (unsigned)__builtin_amdgcn_s_getreg((3 << 11) | 20) & 0xFu; }
#define XB_SPIN(cond, bar) do { unsigned _sp = 0; while (cond) { __builtin_amdgcn_s_sleep(1); \
    if ((++_sp & 255u) == 0u) { if (xb_ld(&(bar)[XB_TMO])) break; if (_sp > XB_SPIN_CAP) { atomicAdd(&(bar)[XB_TMO], 1u); break; } } } } while (0)
struct XcdBarrier { unsigned* bar; unsigned x; volatile LAS unsigned* st; };
__device__ __forceinline__ XcdBarrier xcd_barrier_post(unsigned* bar, volatile LAS unsigned* st) {
    XcdBarrier b; b.bar = bar; b.x = xb_xcc_id(); b.st = st;
    if (threadIdx.x == 0) (void)xb_add(&bar[XB_XCNT(b.x)], 1u);
    return b;
}
__device__ __forceinline__ void xcd_barrier_complete(unsigned* bar, unsigned x, unsigned& nloc, unsigned& nx) {
    const unsigned G = gridDim.x * gridDim.y * gridDim.z;
    unsigned sum, cnt, mine, sp = 0u;
    for (;;) {
        sum = 0u; cnt = 0u; mine = 0u;
#pragma unroll
        for (unsigned j = 0; j < 16; ++j) { const unsigned c = xb_ld(&bar[XB_XCNT(j)]); sum += c; cnt += (c > 0u) ? 1u : 0u; mine = (j == x) ? c : mine; }
        if (sum == G) break;
        __builtin_amdgcn_s_sleep(1);
        if ((++sp & 255u) == 0u) { if (xb_ld(&bar[XB_TMO])) break; if (sp > XB_SPIN_CAP) { atomicAdd(&bar[XB_TMO], 1u); break; } }
    }
    nloc = mine > 0u ? mine : 1u; nx = cnt > 0u ? cnt : 1u;
}
__device__ __forceinline__ void xcd_barrier(const XcdBarrier& b) {
    asm volatile("s_waitcnt vmcnt(0)" ::: "memory");
    __syncthreads();
    if (threadIdx.x == 0) {
        unsigned* bar = b.bar; asm volatile("" : "+s"(bar));
        __builtin_amdgcn_s_waitcnt(0);
        unsigned nloc = b.st[0], nx = b.st[1];
        if (nloc == 0u) { xcd_barrier_complete(bar, b.x, nloc, nx); b.st[0] = nloc; b.st[1] = nx; }
        const unsigned old = xb_add(&bar[XB_XSUB(b.x)], 1u);
        const unsigned gen = old / nloc;
        if (old + 1u == (gen + 1u) * nloc) {
            __builtin_amdgcn_fence(__ATOMIC_RELEASE, "agent");
            asm volatile("s_waitcnt vmcnt(0)" ::: "memory");
            const unsigned og = xb_add(&bar[XB_TOP], 1u);
            const unsigned tg = og / nx;
            if (og + 1u == (tg + 1u) * nx) xb_add(&bar[XB_TOPGEN], 1u);
            else XB_SPIN(xb_ld(&bar[XB_TOPGEN]) == tg, bar);
            __builtin_amdgcn_fence(__ATOMIC_ACQUIRE, "agent");
            xb_add(&bar[XB_XGEN(b.x)], 1u);
            asm volatile("s_waitcnt vmcnt(0)" ::: "memory");
        } else {
            XB_SPIN(xb_ld(&bar[XB_XGEN(b.x)]) == gen, bar);
            __builtin_amdgcn_fence(__ATOMIC_ACQUIRE, "agent");
            asm volatile("s_waitcnt vmcnt(0)" ::: "memory");
        }
    }
    __syncthreads();
}

struct Params { const float* in[14]; float* out; unsigned char* ws; };

__device__ __forceinline__ void transpose_item(const float* W, int K, int N, bf16_t* WT, const float* gain, int mode, LAS float* scr, int item, int lane) {
    asm volatile("" : "+v"(lane));
    const int nblk = N / 32, kb = item / nblk, nb = item % nblk, k0 = 64 * kb, n0 = 32 * nb;
#pragma unroll 8
    for (int i = 0; i < 32; ++i) { const int kk = 2 * i + (lane >> 5); float w = __builtin_nontemporal_load(W + (size_t)(k0 + kk) * N + n0 + (lane & 31)); if (gain) w *= gain[k0 + kk]; scr[kk * 33 + (lane & 31)] = w; }
    int d0 = n0;
    if (mode == 1) { const int j = n0 < DFF ? n0 : n0 - DFF; d0 = 256 * (j >> 7) + (j & 127) + (n0 < DFF ? 0 : 128); }
    const int c = lane & 7;
#pragma unroll
    for (int j = 0; j < 4; ++j) { const int n = (lane >> 3) + 8 * j; const LAS float* s = scr + (8 * c) * 33 + n;
        u32x4 o; o.x = cvtpk(s[0 * 33], s[1 * 33]); o.y = cvtpk(s[2 * 33], s[3 * 33]); o.z = cvtpk(s[4 * 33], s[5 * 33]); o.w = cvtpk(s[6 * 33], s[7 * 33]);
        *(u32x4*)(WT + (size_t)(d0 + n) * K + k0 + 8 * c) = o; }
}

__global__ void __launch_bounds__(NTHREADS) fwd_megakernel(Params P) {
#define GAS __attribute__((address_space(1)))
#define KA(i) ((const float*)(const GAS float*)ka[(i)])
    extern __shared__ __attribute__((aligned(16))) unsigned char lds_raw[];
    cg::grid_group grid = cg::this_grid();
    LAS unsigned char* lds = (LAS unsigned char*)lds_raw;
    const int tid0 = threadIdx.x, wave = __builtin_amdgcn_readfirstlane(tid0 >> 6);
    const int G0 = gridDim.x, bx0 = blockIdx.x;
    const int vcu0 = (G0 % 8 == 0) ? (bx0 % 8) * (G0 / 8) + bx0 / 8 : bx0;
    LAS float* wsf = (LAS float*)(lds + WSF_OFF) + wave * 64;
    volatile LAS unsigned* bst = (volatile LAS unsigned*)(lds + PTAB_OFF);
    if (tid0 < 2) bst[tid0] = 0u;
    __syncthreads();
    XcdBarrier xbar = xcd_barrier_post((unsigned*)(P.ws + WS_BAR), bst);

    for (int ph = 0; ph <= 24; ++ph) {
        const __attribute__((address_space(4))) unsigned long long* ka = (const __attribute__((address_space(4))) unsigned long long*)__builtin_amdgcn_kernarg_segment_ptr(); asm volatile("" : "+s"(ka));
        unsigned char* ws = (unsigned char*)(GAS unsigned char*)ka[15];
        f32x2* rope = (f32x2*)(ws + WS_ROPE);
        float* ssq_all = (float*)(ws + WS_SSQ);
        bf16_t* QKV = (bf16_t*)(ws + WS_QKV); bf16_t* HB = (bf16_t*)(ws + WS_H); bf16_t* OB = (bf16_t*)(ws + WS_O);
        int G = G0, bx = bx0, vcu = vcu0; asm volatile("" : "+s"(G), "+s"(bx), "+s"(vcu));
        const int gw = vcu * NWAVES + wave, NGW = G * NWAVES;
        int tid = tid0; asm volatile("" : "+v"(tid));
        const int lane = tid & 63, r32 = lane & 31, hi = lane >> 5;
        const int c = ph / 12, s = ph % 12;
        const int S = (c == 0) ? 8192 : 4096, nb = RC / S;
        const float* xin = KA(c & 1);
        float* xout = ((float*)(GAS float*)ka[14]) + (size_t)(c & 1) * RC * DM;
        float* ssq = ssq_all + (size_t)(c & 1) * 5 * RC;
        bf16_t* XB = (bf16_t*)(ws + ((c & 1) ? WS_XB1 : WS_XB));
        if (s == 0) {
            if (ph == 0 && (PHM & 1)) {
                LAS float* scr = (LAS float*)(lds + wave * 16384);
                constexpr int I0 = 16 * (NE / 32), I1 = 16 * (DM / 32), I2 = 16 * (NO / 32), I3 = I1, I4 = 16 * (NGU / 32), I5 = I4, I6 = (DFF / 64) * (DM / 32), I7 = I6;
                constexpr int NIT = I0 + I1 + I2 + I3 + I4 + I5 + I6 + I7;
                for (int it = gw; it < NIT; it += NGW) {
                    int r = it;
                    if (r < I0) { transpose_item(KA(5), DM, NE, (bf16_t*)(ws + W_INE), KA(2), 0, scr, r, lane); continue; } r -= I0;
                    if (r < I1) { transpose_item(KA(9), DM, DM, (bf16_t*)(ws + W_OUTE), nullptr, 0, scr, r, lane); continue; } r -= I1;
                    if (r < I2) { transpose_item(KA(10), DM, NO, (bf16_t*)(ws + W_INO), KA(2) + DM, 0, scr, r, lane); continue; } r -= I2;
                    if (r < I3) { transpose_item(KA(11), DM, DM, (bf16_t*)(ws + W_OUTO), nullptr, 0, scr, r, lane); continue; } r -= I3;
                    if (r < I4) { transpose_item(KA(12), DM, NGU, (bf16_t*)(ws + W_GU0), KA(3), 1, scr, r, lane); continue; } r -= I4;
                    if (r < I5) { transpose_item(KA(12) + (size_t)DM * NGU, DM, NGU, (bf16_t*)(ws + W_GU1), KA(3) + DM, 1, scr, r, lane); continue; } r -= I5;
                    if (r < I6) { transpose_item(KA(13), DFF, DM, (bf16_t*)(ws + W_DN0), nullptr, 0, scr, r, lane); continue; } r -= I6;
                    transpose_item(KA(13) + (size_t)DFF * DM, DFF, DM, (bf16_t*)(ws + W_DN1), nullptr, 0, scr, r, lane);
                }
                const int gt = vcu * NTHREADS + tid;
                if (gt < 2048) { const int pos = gt >> 4, i = gt & 15; const float fr = __builtin_amdgcn_exp2f(-(float)i * (13.287712379549449f / 16.f)); const float ang = (float)pos * fr;
                    float sn, cs; sincosf(ang, &sn, &cs); rope[gt] = (f32x2){cs, sn}; }
            }
            if (c >= 1) {
                float* po = ((float*)(GAS float*)ka[14]) + (size_t)(c - 1) * RC * DM; const float* pq = ssq_all + (size_t)(c - 1) * 5 * RC + 4 * RC; const float* gf = KA(4);
                const bf16_t* xp = (const bf16_t*)(ws + (((c - 1) & 1) ? WS_XB1 : WS_XB));
                for (int row = gw; row < RC; row += NGW) { const float rs = __builtin_amdgcn_rsqf(pq[row] * (1.f / DM) + EPS);
#pragma unroll
                    for (int hf = 0; hf < 2; ++hf) { const u32x4 r = __builtin_nontemporal_load((const u32x4*)(xp + (size_t)row * DM + hf * 512 + lane * 8));
                        const f32x4 g0 = *(const f32x4*)(gf + hf * 512 + lane * 8), g1 = *(const f32x4*)(gf + hf * 512 + lane * 8 + 4);
                        f32x4 y0, y1;
                        y0[0] = __builtin_bit_cast(float, r.x << 16); y0[1] = __builtin_bit_cast(float, r.x & 0xffff0000u); y0[2] = __builtin_bit_cast(float, r.y << 16); y0[3] = __builtin_bit_cast(float, r.y & 0xffff0000u);
                        y1[0] = __builtin_bit_cast(float, r.z << 16); y1[1] = __builtin_bit_cast(float, r.z & 0xffff0000u); y1[2] = __builtin_bit_cast(float, r.w << 16); y1[3] = __builtin_bit_cast(float, r.w & 0xffff0000u);
                        f32x4* op = (f32x4*)(po + (size_t)row * DM + hf * 512 + lane * 8);
                        __builtin_nontemporal_store(y0 * rs * g0, op); __builtin_nontemporal_store(y1 * rs * g1, op + 1); } }
            }
            if (c < 2) {
                for (int row = gw; row < RC; row += NGW) { const f32x4* xr = (const f32x4*)(xin + (size_t)row * DM) + lane; f32x4 v[4]; float sq = 0.f;
#pragma unroll
                    for (int j = 0; j < 4; ++j) { v[j] = __builtin_nontemporal_load(xr + 64 * j); sq += (v[j].x * v[j].x + v[j].y * v[j].y) + (v[j].z * v[j].z + v[j].w * v[j].w); }
                    sq = wave_sum(sq); u32x2* o8 = (u32x2*)(XB + (size_t)row * DM) + lane;
#pragma unroll
                    for (int j = 0; j < 4; ++j) o8[64 * j] = (u32x2){cvtpk(v[j].x, v[j].y), cvtpk(v[j].z, v[j].w)};
                    if (lane < 5) ssq[(size_t)lane * RC + row] = lane == 0 ? sq : 0.f; }
            }
        } else if ((s == 1 || s == 7) && (PHM & 2)) {
            const int N = (s == 1) ? NE : NO;
            pg8::Gemm g{XB, (const bf16_t*)(ws + (s == 1 ? W_INE : W_INO)), RC, N, DM}; pg8::StaticOrder SO; SO.init(RC, N, G, bx);
            pg8::EpiScaleBf16 E{QKV, (s == 1) ? NEP : NOP, ssq + (s == 1 ? 0 : 2) * (size_t)RC, (s == 1) ? 3 : 0, (s == 1) ? 5 : 4, C2};
            for (int rep = 0; rep < ((DUP & 4) ? 2 : 1); ++rep) pg8::gemm_phase<pg8::EpiScaleBf16>(lds, g, SO, E, wave);
        } else if ((s == 4 || s == 6 || s == 9 || s == 11) && (PHM & 4)) {
            const bool dn = (s == 6 || s == 11); const int K = dn ? DFF : DM;
            const size_t woff = (s == 4) ? W_OUTE : (s == 6) ? W_DN0 : (s == 9) ? W_OUTO : W_DN1;
            pg8::Gemm g{dn ? HB : OB, (const bf16_t*)(ws + woff), RC, DM, K}; pg8::StaticOrder SO; SO.init(RC, DM, G, bx);
            const int qi = (s == 4) ? 1 : (s == 6) ? 2 : (s == 9) ? 3 : 4;
            pg8::EpiResidual E{XB, ssq + (size_t)qi * RC};
            pg8::gemm_phase<pg8::EpiResidual>(lds, g, SO, E, wave);
        } else if ((s == 5 || s == 10) && (PHM & 8)) {
            pg8::Gemm g{XB, (const bf16_t*)(ws + (s == 5 ? W_GU0 : W_GU1)), RC, NGU, DM}; pg8::StaticOrder SO; SO.init(RC, NGU, G, bx);
            pg8::EpiSwiGLU E{HB, ssq + (size_t)(s == 5 ? 1 : 3) * RC};
            for (int rep = 0; rep < ((DUP & 4) ? 2 : 1); ++rep) pg8::gemm_phase<pg8::EpiSwiGLU>(lds, g, SO, E, wave);
        } else if (s == 2 && (PHM & 16)) {
            const float* gq = KA(6); const float* gk = KA(7);
            for (int row = gw; row < RC; row += NGW) { const int t = row & (S - 1), pr = t >> 6, pc = t & 63;
#pragma unroll
                for (int pass = 0; pass < 2; ++pass) { const int hh0 = (lane >> 3) + 8 * pass; const bool act = hh0 < 10; const int hh = act ? hh0 : 9; const int cc = lane & 7;
                    bf16_t* ptr = QKV + (size_t)row * NEP + hh * 64 + cc * 8; const u32x4 raw = *(const u32x4*)ptr; const float* gn = (hh < 8 ? gq : gk) + cc * 8;
                    float y[8]; y[0] = bf2f(raw.x & 0xffff); y[1] = bf2f(raw.x >> 16); y[2] = bf2f(raw.y & 0xffff); y[3] = bf2f(raw.y >> 16); y[4] = bf2f(raw.z & 0xffff); y[5] = bf2f(raw.z >> 16); y[6] = bf2f(raw.w & 0xffff); y[7] = bf2f(raw.w >> 16);
                    float sq = 0.f;
#pragma unroll
                    for (int j = 0; j < 8; ++j) sq += y[j] * y[j];
                    sq += __shfl_xor(sq, 1); sq += __shfl_xor(sq, 2); sq += __shfl_xor(sq, 4);
                    const float rn = __builtin_amdgcn_rsqf(sq * (1.f / 64.f) + EPS);
                    const int pos = (cc >> 2) ? pc : pr; const f32x2* tb = rope + pos * 16 + (cc & 1) * 8; const bool first = (cc & 3) < 2; const float sc = hh < 8 ? C2 : 1.f;
                    float ov[8];
#pragma unroll
                    for (int j = 0; j < 8; ++j) { const float yy = y[j] * rn * gn[j]; const float py = __shfl_xor(yy, 2); const f32x2 cs = tb[j];
                        ov[j] = (first ? (yy * cs.x - py * cs.y) : (py * cs.y + yy * cs.x)) * sc; }
                    if (act) *(u32x4*)ptr = (u32x4){cvtpk(ov[0], ov[1]), cvtpk(ov[2], ov[3]), cvtpk(ov[4], ov[5]), cvtpk(ov[6], ov[7])}; } }
            { LAS float* tabL = (LAS float*)(lds + RPB_OFF); const float* rpb = KA(8);
              for (int i = tid; i < 3720; i += NTHREADS) tabL[i] = rpb[i] * LOG2E;
              __syncthreads();
              const int rows = S >> 6; const int ntask = nb * rows * 16;
              LAS unsigned char* wl = lds + wave * 16384;
              for (int rep = 0; rep < ((DUP & 2) ? 2 : 1); ++rep)
              for (int wt = gw; wt < ntask; wt += NGW) {
                  const int qh = wt & 1, h = (wt >> 1) & 7, br = wt >> 4, r = br % rows, b = br / rows;
                  const int rs0 = min(max(r - 4, 0), rows - 8);
                  const size_t rowbase = (size_t)b * S;
                  const int qc = qh * 32 + r32, cs = min(max(qc - 8, 0), 48);
                  const bf16_t* qp = QKV + (rowbase + r * 64 + qc) * NEP + 768 + h * 64 + hi * 8;
                  bf16x8 qr[4];
#pragma unroll
                  for (int d0 = 0; d0 < 4; ++d0) qr[d0] = *(const bf16x8*)(qp + d0 * 16);
                  f32x16 o[2]; o[0] = (f32x16){}; o[1] = (f32x16){}; f32x16 negm = (f32x16){}; float mref = 0.f, l = 0.f;
                  const int lrow = lane >> 3, ch = lane & 7;
                  const int lrowV = 2 * (lane >> 4) + ((lane >> 2) & 1), dhV = (lane >> 3) & 1, cwV = lane & 3;
                  const int cbase = 24 * qh;
                  const bf16_t* kp = QKV + (rowbase + (size_t)rs0 * 64 + cbase + lrow) * NEP + 1280 + h * 64 + ch * 8;
                  const bf16_t* vp = QKV + (rowbase + (size_t)rs0 * 64 + cbase + lrowV) * NEP + 1792 + h * 64 + dhV * 32 + cwV * 8;
                  u32x4 kr[8], vr[8];
#define NAP_LOAD(T_) do { _Pragma("unroll") for (int j = 0; j < 8; ++j) { const int g_ = 8 * (T_) + j, kr_ = (g_ * 205) >> 10, kc_ = g_ - 5 * kr_; const size_t off_ = (size_t)(kr_ * 64 + kc_ * 8) * NEP; \
                      kr[j] = *(const u32x4*)(kp + off_); vr[j] = *(const u32x4*)(vp + off_); } } while (0)
                  NAP_LOAD(0);
                  const int kcs = 4 * hi - cs;
                  for (int jt = 0; jt < 5; ++jt) {
                      LAS unsigned char* kw = wl + ch * 1024 + (lrow ^ ch) * 16; LAS unsigned char* vw = wl + 8192 + dhV * 4096 + lrowV * 64 + cwV * 16; asm volatile("" : "+v"(kw), "+v"(vw));
#pragma unroll
                      for (int j = 0; j < 8; ++j) { *(LAS u32x4*)(kw + j * 128) = kr[j]; *(LAS u32x4*)(vw + j * 512) = vr[j]; }
                      int kcs_ = kcs; asm volatile("" : "+v"(kcs_));
                      ModNAP mod; mod.kcs = kcs_; mod.tl = tabL + (15 - qc + 4 * hi);
#pragma unroll
                      for (int g = 0; g < 8; ++g) { const int g_ = 8 * jt + g, kr_ = (g_ * 205) >> 10, kc_ = g_ - 5 * kr_; mod.C8[g] = cbase + kc_ * 8; mod.U[g] = (h * 15 + (rs0 + kr_ - r + 7)) * 31 + cbase + kc_ * 8; }
                      bf16x8 pa[4];
                      if (jt + 1 < 5) NAP_LOAD(jt + 1);
                      f32x16 s0, s1;
                      qkt2(s0, s1, wl, qr, negm, r32, hi);
                      softmax2<false>(s0, s1, o, negm, mref, l, wsf, lane, mod, pa, s0, s1);
                      pv_lane(o, wl + 8192, pa, lane);
                      asm volatile("" ::: "memory");
                  }
#undef NAP_LOAD
                  flash_finish(o, l, wsf, wl, OB + (rowbase + r * 64 + qh * 32) * DM + 512 + h * 64, DM, lane);
              } }
        } else if (s == 3 && (PHM & 32)) {
            const int nqb = S >> 8, ntask = nb * 8 * nqb, NT = S >> 6;
            LAS unsigned char* stg = lds + 81920 + wave * 4096;
            float gqm = 0.f, gkm = 0.f;
            { const float* gq = KA(6); const float* gk = KA(7);
              for (int i = 0; i < 64; ++i) { gqm = fmaxf(gqm, __builtin_fabsf(gq[i])); gkm = fmaxf(gkm, __builtin_fabsf(gk[i])); } }
            const float sbound = 64.f * C2 * gqm * gkm * 1.001f;
            const bool fastA = sbound < 64.f;
            for (int rep = 0; rep < ((DUP & 1) ? 2 : 1); ++rep)
            for (int task = vcu; task < ntask; task += G) {
                const int qb = task % nqb, bh = task / nqb, h = bh & 7, b = bh >> 3;
                const size_t rowbase = (size_t)b * S;
                const int q0 = qb * 256 + wave * 32;
                const bf16_t* qp = QKV + (rowbase + q0 + r32) * NEP + h * 64 + hi * 8;
                bf16x8 qr[4];
#pragma unroll
                for (int d0 = 0; d0 < 4; ++d0) qr[d0] = *(const bf16x8*)(qp + d0 * 16);
                f32x16 o[2]; o[0] = (f32x16){}; o[1] = (f32x16){}; float l = 0.f;
                const int trow = wave * 8 + (lane >> 3), ch = lane & 7;
                const int trowV = wave * 8 + 2 * (lane >> 4) + ((lane >> 2) & 1), dhV = (lane >> 3) & 1, cwV = lane & 3;
                const bf16_t* kp = QKV + (rowbase + trow) * NEP + 512 + (h >> 2) * 64 + ch * 8;
                const bf16_t* vp = QKV + (rowbase + trowV) * NEP + 640 + (h >> 2) * 64 + dhV * 32 + cwV * 8;
                const unsigned kdst = ch * 1024 + (trow ^ ch) * 16, vdst = 8192 + dhV * 4096 + trowV * 64 + cwV * 16;
                u32x4 kreg = *(const u32x4*)kp, vreg = *(const u32x4*)vp;
                if (!fastA) {
                    float m = -1e30f;
                    *(LAS u32x4*)(lds + kdst) = kreg; *(LAS u32x4*)(lds + vdst) = vreg;
                    __syncthreads();
                    for (int t = 0; t < NT; ++t) {
                        const unsigned cur = (t & 1) * 16384u, nxt = 16384u - cur;
                        if (t + 1 < NT) { kreg = *(const u32x4*)(kp + (size_t)(t + 1) * 64 * NEP); vreg = *(const u32x4*)(vp + (size_t)(t + 1) * 64 * NEP); }
                        flash_step(lds + cur, lds + cur + 8192, qr, o, m, l, wsf, lane, ModNone{});
                        if (t + 1 < NT) { *(LAS u32x4*)(lds + nxt + kdst) = kreg; *(LAS u32x4*)(lds + nxt + vdst) = vreg; }
                        __syncthreads();
                    }
                    flash_finish(o, l, wsf, stg, OB + (rowbase + q0) * DM + h * 64, DM, lane);
                    continue;
                }
                u32x4 kreg1 = *(const u32x4*)(kp + (size_t)64 * NEP), vreg1 = *(const u32x4*)(vp + (size_t)64 * NEP);
                u32x4 kreg2 = *(const u32x4*)(kp + (size_t)128 * NEP), vreg2 = *(const u32x4*)(vp + (size_t)128 * NEP);
                *(LAS u32x4*)(lds + kdst) = kreg; *(LAS u32x4*)(lds + vdst) = vreg;
                *(LAS u32x4*)(lds + 16384 + kdst) = kreg1; *(LAS u32x4*)(lds + 16384 + vdst) = vreg1;
                *(LAS u32x4*)(lds + 32768 + kdst) = kreg2; *(LAS u32x4*)(lds + 32768 + vdst) = vreg2;
                __syncthreads();
                f32x16 sa0, sa1, sb0, sb1;
                { const f32x16 z_ = (f32x16){}; qkt2(sa0, sa1, lds, qr, z_, r32, hi); }
                unsigned bcur = 0, bnxt = 16384, bnn = 49152;
                const int vbl = ((lane >> 4) & 1) * 32 + (lane & 3) * 8 + (4 * hi + ((lane & 15) >> 2)) * 64;
#define A_SCHED __builtin_amdgcn_sched_barrier(0)
#define A_STEP(C0, C1, N0, N1, T_) do { \
                    if ((T_) + 3 < NT) { kreg = *(const u32x4*)(kp + (size_t)((T_) + 3) * 64 * NEP); vreg = *(const u32x4*)(vp + (size_t)((T_) + 3) * 64 * NEP); } \
                    bf16x8 kf[4], kg[4]; \
                    { _Pragma("unroll") for (int d0 = 0; d0 < 2; ++d0) { LAS const unsigned char* kb_ = lds + bnxt + (2 * d0 + hi) * 1024 + ((r32 ^ (2 * d0 + hi)) * 16); asm volatile("" : "+v"(kb_)); \
                        kf[2 * d0] = *(LAS const bf16x8*)(kb_); kf[2 * d0 + 1] = *(LAS const bf16x8*)(kb_ + 512); } } \
                    A_SCHED; \
                    { _Pragma("unroll") for (int d0 = 2; d0 < 4; ++d0) { LAS const unsigned char* kb_ = lds + bnxt + (2 * d0 + hi) * 1024 + ((r32 ^ (2 * d0 + hi)) * 16); asm volatile("" : "+v"(kb_)); \
                        kg[2 * d0 - 4] = *(LAS const bf16x8*)(kb_); kg[2 * d0 - 3] = *(LAS const bf16x8*)(kb_ + 512); } } \
                    N0 = __builtin_amdgcn_mfma_f32_32x32x16_bf16(kf[0], qr[0], (f32x16){}, 0, 0, 0); N1 = __builtin_amdgcn_mfma_f32_32x32x16_bf16(kf[1], qr[0], (f32x16){}, 0, 0, 0); \
                    N0 = __builtin_amdgcn_mfma_f32_32x32x16_bf16(kf[2], qr[1], N0, 0, 0, 0);   N1 = __builtin_amdgcn_mfma_f32_32x32x16_bf16(kf[3], qr[1], N1, 0, 0, 0); \
                    A_SCHED; \
                    N0 = __builtin_amdgcn_mfma_f32_32x32x16_bf16(kg[0], qr[2], N0, 0, 0, 0);   N1 = __builtin_amdgcn_mfma_f32_32x32x16_bf16(kg[1], qr[2], N1, 0, 0, 0); \
                    N0 = __builtin_amdgcn_mfma_f32_32x32x16_bf16(kg[2], qr[3], N0, 0, 0, 0);   N1 = __builtin_amdgcn_mfma_f32_32x32x16_bf16(kg[3], qr[3], N1, 0, 0, 0); \
                    A_SCHED; \
                    s16x4 vlo[4], vhi[4]; \
                    { LAS const unsigned char* vp_ = lds + bcur + 8192 + vbl; asm volatile("" : "+v"(vp_)); \
                      _Pragma("unroll") for (int i = 0; i < 4; ++i) { vlo[i] = vtr(vp_ + (i & 3) * 1024); vhi[i] = vtr(vp_ + (i & 3) * 1024 + 512); } } \
                    A_SCHED; \
                    float s_ = 0.f; \
                    _Pragma("unroll") for (int r = 0; r < 16; ++r) { C0[r] = __builtin_amdgcn_exp2f(C0[r]); C1[r] = __builtin_amdgcn_exp2f(C1[r]); s_ += C0[r] + C1[r]; } \
                    l += s_; \
                    bf16x8 pa[4]; \
                    { u32x4 w; \
                      w = (u32x4){cvtpk(C0[0], C0[1]), cvtpk(C0[2], C0[3]), cvtpk(C0[4], C0[5]), cvtpk(C0[6], C0[7])}; pa[0] = __builtin_bit_cast(bf16x8, w); \
                      w = (u32x4){cvtpk(C0[8], C0[9]), cvtpk(C0[10], C0[11]), cvtpk(C0[12], C0[13]), cvtpk(C0[14], C0[15])}; pa[1] = __builtin_bit_cast(bf16x8, w); \
                      w = (u32x4){cvtpk(C1[0], C1[1]), cvtpk(C1[2], C1[3]), cvtpk(C1[4], C1[5]), cvtpk(C1[6], C1[7])}; pa[2] = __builtin_bit_cast(bf16x8, w); \
                      w = (u32x4){cvtpk(C1[8], C1[9]), cvtpk(C1[10], C1[11]), cvtpk(C1[12], C1[13]), cvtpk(C1[14], C1[15])}; pa[3] = __builtin_bit_cast(bf16x8, w); } \
                    A_SCHED; \
                    _Pragma("unroll") for (int i = 0; i < 4; ++i) { const bf16x8 vf = (bf16x8){vlo[i][0], vlo[i][1], vlo[i][2], vlo[i][3], vhi[i][0], vhi[i][1], vhi[i][2], vhi[i][3]}; \
                        o[0] = __builtin_amdgcn_mfma_f32_32x32x16_bf16(pa[i], vf, o[0], 0, 0, 0); } \
                    A_SCHED; \
                    { LAS const unsigned char* vp_ = lds + bcur + 8192 + 4096 + vbl; asm volatile("" : "+v"(vp_)); \
                      _Pragma("unroll") for (int i = 0; i < 4; ++i) { vlo[i] = vtr(vp_ + i * 1024); vhi[i] = vtr(vp_ + i * 1024 + 512); } } \
                    if ((T_) + 3 < NT) { *(LAS u32x4*)(lds + bnn + kdst) = kreg; *(LAS u32x4*)(lds + bnn + vdst) = vreg; } \
                    A_SCHED; \
                    _Pragma("unroll") for (int i = 0; i < 4; ++i) { const bf16x8 vf = (bf16x8){vlo[i][0], vlo[i][1], vlo[i][2], vlo[i][3], vhi[i][0], vhi[i][1], vhi[i][2], vhi[i][3]}; \
                        o[1] = __builtin_amdgcn_mfma_f32_32x32x16_bf16(pa[i], vf, o[1], 0, 0, 0); } \
                    if (BAR_) __syncthreads(); \
                    bcur = bnxt; bnxt = (bnxt == 65536u) ? 0u : bnxt + 16384u; bnn = (bnn == 65536u) ? 0u : bnn + 16384u; \
                } while (0)
                for (int t = 0; t < NT; t += 2) {
#define BAR_ false
                    A_STEP(sa0, sa1, sb0, sb1, t);
#undef BAR_
#define BAR_ true
                    A_STEP(sb0, sb1, sa0, sa1, t + 1);
#undef BAR_
                }
#undef A_STEP
#undef A_SCHED
                flash_finish(o, l, wsf, stg, OB + (rowbase + q0) * DM + h * 64, DM, lane);
            }
        } else if (s == 8 && (PHM & 64)) {
            const int nib = S >> 9, nqb = S >> 5;
            LAS unsigned char* wl = lds + wave * 16384;
            float* LSE = (float*)(ws + WS_LSE);
            for (int pass = 0; pass < 2; ++pass) {
            const int ntask = pass == 0 ? nb * 16 * nqb : nb * 16 * nib * 16;
            const int qstep = pass == 0 ? 1 : 16, ubeg = pass == 0 ? 0 : 10, uend = pass == 0 ? 3 : 17;
            for (int wt = gw; wt < ntask; wt += NGW) {
                int tmin, h, b;
                if (pass == 0) { const int qb = wt % nqb, bh = wt / nqb; h = bh & 15; b = bh >> 4; tmin = qb * 32; }
                else { const int rho = wt & 15, ib = (wt >> 4) % nib, bh = (wt >> 4) / nib; h = bh & 15; b = bh >> 4; tmin = rho + 512 * ib; }
                const size_t rowbase = (size_t)b * S;
                const int tq = tmin + qstep * r32;
                const float slope2 = __builtin_amdgcn_exp2f(-0.5f * (float)(h + 1)) * LOG2E;
                const bf16_t* qp = QKV + (rowbase + tq) * NOP + h * 64 + hi * 8;
                bf16x8 qr[4];
#pragma unroll
                for (int d0 = 0; d0 < 4; ++d0) qr[d0] = *(const bf16x8*)(qp + d0 * 16);
                f32x16 o[2]; o[0] = (f32x16){}; o[1] = (f32x16){}; f32x16 negm = (f32x16){}; float mref = 0.f, l = 0.f;
                const int lrow = lane >> 3, ch = lane & 7;
                const int lrowV = 2 * (lane >> 4) + ((lane >> 2) & 1), dhV = (lane >> 3) & 1, cwV = lane & 3;
                const bf16_t* kb = QKV + rowbase * NOP + 1024 + h * 64 + ch * 8;
                const bf16_t* vb = QKV + rowbase * NOP + 2048 + h * 64 + dhV * 32 + cwV * 8;
                u32x4 kr[8], vr[8];
#define DIL_TILE(u, SH, T0) do { const int g_ = (u) < 10 ? 0 : ((u) < 14 ? 1 : 2); SH = 2 * g_; const int tt_ = (u) - (g_ == 0 ? 0 : (g_ == 1 ? 10 : 14)); T0 = tmin - (64 << SH) + ((64 * tt_) << SH); } while (0)
#define DIL_LOADK(SH, T0) do { int lr_ = lrow; asm volatile("" : "+v"(lr_)); _Pragma("unroll") for (int j = 0; j < 8; ++j) { const int tk_ = min(max(T0 + ((lr_ + 8 * j) << SH), 0), S - 1); kr[j] = *(const u32x4*)(kb + (size_t)tk_ * NOP); } } while (0)
#define DIL_LOADV(SH, T0) do { int lr_ = lrowV; asm volatile("" : "+v"(lr_)); _Pragma("unroll") for (int j = 0; j < 8; ++j) { const int tv_ = min(max(T0 + ((lr_ + 8 * j) << SH), 0), S - 1); vr[j] = *(const u32x4*)(vb + (size_t)tv_ * NOP); } } while (0)
                int sh, t0; DIL_TILE(ubeg, sh, t0); DIL_LOADK(sh, t0); DIL_LOADV(sh, t0);
                for (int u = ubeg; u < uend; ++u) {
                    LAS unsigned char* kw = wl + ch * 1024 + (lrow ^ ch) * 16; LAS unsigned char* vw = wl + 8192 + dhV * 4096 + lrowV * 64 + cwV * 16; asm volatile("" : "+v"(kw), "+v"(vw));
#pragma unroll
                    for (int j = 0; j < 8; ++j) { *(LAS u32x4*)(kw + j * 128) = kr[j]; *(LAS u32x4*)(vw + j * 512) = vr[j]; }
                    int tq_ = tq; asm volatile("" : "+v"(tq_));
                    ModDil mod{(float)(tq_ - t0 - ((4 * hi) << sh)), (float)(1 << sh), (float)(64 << sh), slope2, (float)tq_, (float)(tq_ - S), (t0 >= 0) && (t0 + (63 << sh) < S)};
                    bf16x8 pa[4];
                    if (u + 1 < uend) { DIL_TILE(u + 1, sh, t0); DIL_LOADK(sh, t0); }
                    f32x16 s0, s1;
                    qkt2(s0, s1, wl, qr, negm, r32, hi);
                    softmax2<false>(s0, s1, o, negm, mref, l, wsf, lane, mod, pa, s0, s1);
                    asm volatile("" ::: "memory");
                    if (u + 1 < uend) { DIL_LOADV(sh, t0); }
                    pv_lane(o, wl + 8192, pa, lane);
                    asm volatile("" ::: "memory");
                }
#undef DIL_TILE
#undef DIL_LOADK
#undef DIL_LOADV
                flash_finish_c(o, l, mref, wsf, wl, OB + (rowbase + tmin) * DM + h * 64, (size_t)qstep * DM, lane, LSE + (rowbase + tmin) * 16 + h, qstep * 16, pass == 1);
            }
            if (pass == 0) xcd_barrier(xbar);
            }
        }
        if (ph == 0) grid.sync(); else if (ph < 24) xcd_barrier(xbar);
    }
}

#undef KA
extern "C" void kernel_launch(void* const* d_in, const int* in_sizes, int n_in, void* d_out, int out_size, void* d_ws, size_t ws_size, hipStream_t stream) {
    static int grid_blocks = 0;
    if (!grid_blocks) {
        int dev = 0, cus = 0, per_cu = 0;
        hipGetDevice(&dev);
        hipDeviceGetAttribute(&cus, hipDeviceAttributeMultiprocessorCount, dev);
        hipFuncSetAttribute((const void*)fwd_megakernel, hipFuncAttributeMaxDynamicSharedMemorySize, LDS_BYTES);
        hipOccupancyMaxActiveBlocksPerMultiprocessor(&per_cu, (const void*)fwd_megakernel, NTHREADS, LDS_BYTES);
        if (per_cu < 1) per_cu = 1;
        grid_blocks = cus * per_cu;
        if (n_in != 14 || ws_size < WS_END) fprintf(stderr, "kernel_launch: unexpected n_in %d / ws_size %zu\n", n_in, ws_size);
    }
    (void)hipMemsetAsync((char*)d_ws + WS_BAR, 0, 16384, stream);
    Params p{};
    for (int i = 0; i < 14; ++i) p.in[i] = (const float*)d_in[i];
    p.out = (float*)d_out; p.ws = (unsigned char*)d_ws;
    void* args[] = {&p};
    hipError_t e = hipLaunchCooperativeKernel((const void*)fwd_megakernel, dim3(grid_blocks), dim3(NTHREADS), args, LDS_BYTES, stream);
    if (e != hipSuccess) fprintf(stderr, "cooperative launch failed: %s (grid %d)\n", hipGetErrorString(e), grid_blocks);
}
```

```cpp
#include <hip/hip_runtime.h>
#include <hip/hip_cooperative_groups.h>
#include <cstdio>
#include <cstdint>
namespace cg = cooperative_groups;

#define LAS __attribute__((address_space(3)))
typedef unsigned short bf16_t;
typedef short bf16x8 __attribute__((ext_vector_type(8)));
typedef short s16x4 __attribute__((ext_vector_type(4)));
typedef float f32x2 __attribute__((ext_vector_type(2)));
typedef float f32x4 __attribute__((ext_vector_type(4)));
typedef float f32x16 __attribute__((ext_vector_type(16)));
typedef unsigned u32x2 __attribute__((ext_vector_type(2)));
typedef unsigned u32x4 __attribute__((ext_vector_type(4)));
typedef __bf16 bf16x2_t __attribute__((ext_vector_type(2)));

constexpr int DM = 1024, DFF = 2816, RC = 65536;
constexpr int NE = 2304, NO = 3072, NGU = 5632;
constexpr int NEP = NE + 64, NOP = NO + 64;
constexpr float EPS = 1e-6f, LOG2E = 1.4426950408889634f, C2 = 0.125f * 1.4426950408889634f;
constexpr int NTHREADS = 512, NWAVES = 8;
#ifndef PHM
#define PHM 127
#endif
#ifndef DUP
#define DUP 0
#endif

constexpr size_t MiB = 1u << 20;
constexpr size_t WS_ROPE = 0;
constexpr size_t WS_BAR = 65536;
constexpr size_t WS_SSQ = 1 * MiB;
constexpr size_t WS_W = 4 * MiB;
constexpr size_t W_INE = WS_W, W_OUTE = W_INE + (size_t)NE * DM * 2, W_INO = W_OUTE + (size_t)DM * DM * 2, W_OUTO = W_INO + (size_t)NO * DM * 2;
constexpr size_t W_GU0 = W_OUTO + (size_t)DM * DM * 2, W_GU1 = W_GU0 + (size_t)NGU * DM * 2, W_DN0 = W_GU1 + (size_t)NGU * DM * 2, W_DN1 = W_DN0 + (size_t)DM * DFF * 2;
constexpr size_t W_END = W_DN1 + (size_t)DM * DFF * 2;
constexpr size_t WS_XB = 52 * MiB;
constexpr size_t WS_QKV = 180 * MiB;
constexpr size_t WS_H = 180 * MiB;
constexpr size_t WS_O = 576 * MiB;
constexpr size_t WS_XB1 = 704 * MiB;
constexpr size_t WS_LSE = 832 * MiB;
constexpr size_t WS_END = 836 * MiB;
static_assert(W_END <= WS_XB, "weights fit");
static_assert(WS_QKV + (size_t)RC * NOP * 2 <= WS_O && WS_H + (size_t)RC * DFF * 2 <= WS_O, "qkv/h fit");

constexpr int RING_BYTES = 131072;
constexpr int WSF_OFF = RING_BYTES;
constexpr int RPB_OFF = WSF_OFF + 2048;
constexpr int PTAB_OFF = 148736;
constexpr int LDS_BYTES = 151552;
static_assert(RPB_OFF + 3720 * 4 + 512 <= PTAB_OFF && PTAB_OFF + 128 <= LDS_BYTES, "lds map");
__device__ __forceinline__ const float* ldptr(LAS const unsigned long long* tab, int i) {
    const unsigned long long v = tab[i];
    const unsigned lo = __builtin_amdgcn_readfirstlane((unsigned)v), hi = __builtin_amdgcn_readfirstlane((unsigned)(v >> 32));
    return (const float*)(((unsigned long long)hi << 32) | lo);
}

__device__ __forceinline__ unsigned cvtpk(float lo, float hi) { f32x2 v = {lo, hi}; bf16x2_t b = __builtin_convertvector(v, bf16x2_t); return __builtin_bit_cast(unsigned, b); }
__device__ __forceinline__ float bf2f(unsigned short h) { return __builtin_bit_cast(float, (unsigned)h << 16); }
__device__ __forceinline__ float wave_sum(float v) {
#pragma unroll
    for (int o = 1; o < 64; o <<= 1) v += __shfl_xor(v, o);
    return v;
}

namespace pg8 {
constexpr int BM = 256, BK = 64, HALF = 128, HTB = HALF * BK * 2, STAGE_BYTES = 8 * HTB, NXCD = 8, WGM = 8;
__host__ __device__ __forceinline__ int lds_byte(int r, int c) { const int st = (r >> 4) * 2 + (c >> 5), rr = r & 15, cc = c & 31, ob = rr * 64 + cc * 2; return st * 1024 + (ob ^ (((ob >> 9) & 1) << 5)); }
__host__ __device__ __forceinline__ void stage_rc(int b, int& R, int& C) { const int st = b / 1024, sb = b % 1024, swz = sb ^ (((sb >> 9) & 1) << 5); R = (st >> 1) * 16 + swz / 64; C = (st & 1) * 32 + (swz % 64) / 2; }
__host__ __device__ __forceinline__ int perm32(int rho) { const int n = rho >> 4, i = rho & 15; return 8 * (i >> 2) + 4 * n + (i & 3); }
struct Unit { int pm, pn; };
struct Gemm { const bf16_t* A; const bf16_t* Bt; int M, N, K; };
struct StaticOrder {
    int nM, nN, nwg, G, c;
    __host__ __device__ void init(int M, int N, int G_, int c_) { nM = M / BM; nN = N / BM; nwg = nM * nN; G = G_; c = c_; }
    __host__ __device__ bool next(int i, Unit& u) const {
        const long L = (long)i * G + c; if (L >= nwg) return false;
        int wgid = (int)L; { const int q = nwg / NXCD, r = nwg % NXCD, xcd = wgid % NXCD, off = wgid / NXCD; wgid = (xcd < r ? xcd * (q + 1) : r * (q + 1) + (xcd - r) * q) + off; }
        const int nig = WGM * nN, gid = wgid / nig, fm = gid * WGM, gsz = (nM - fm) < WGM ? (nM - fm) : WGM;
        u.pm = fm + ((wgid % nig) % gsz); u.pn = (wgid % nig) / gsz; return true;
    }
};

struct EpiScaleBf16 {
    static constexpr bool PERM = true;
    bf16_t* O; int ldc; const float* ssq; int t0, t1; float tscale;
    __device__ __forceinline__ void pre(const Unit& u, int wr, int fr, float (&pv)[8]) const {
        const int row0 = u.pm * BM + wr * 64 + fr;
#pragma unroll
        for (int i = 0; i < 8; ++i) pv[i] = ssq[row0 + (i >> 2) * HALF + (i & 3) * 16];
    }
    __device__ __forceinline__ void operator()(const f32x4 (&acc)[2][2][4][2], const Unit& u, int wr, int wc, int fr, int fq, const float (&pv)[8]) const {
        const int row0 = u.pm * BM + wr * 64 + fr, col0 = u.pn * BM + wc * 32 + 8 * fq;
        const float sc = (u.pn >= t0 && u.pn < t1) ? tscale : 1.f;
#pragma unroll
        for (int ai = 0; ai < 2; ++ai)
#pragma unroll
            for (int m = 0; m < 4; ++m) { const int row = row0 + ai * HALF + m * 16; const float rs = __builtin_amdgcn_rsqf(pv[ai * 4 + m] * (1.f / DM) + EPS) * sc;
                bf16_t* rowp = O + (size_t)row * ldc + col0;
#pragma unroll
                for (int bj = 0; bj < 2; ++bj) { const f32x4 v0 = acc[ai][bj][m][0] * rs, v1 = acc[ai][bj][m][1] * rs;
                    u32x4 w; w.x = cvtpk(v0[0], v0[1]); w.y = cvtpk(v0[2], v0[3]); w.z = cvtpk(v1[0], v1[1]); w.w = cvtpk(v1[2], v1[3]);
                    *(u32x4*)(rowp + bj * HALF) = w; } }
    }
};
struct EpiSwiGLU {
    static constexpr bool PERM = true;
    bf16_t* H; const float* ssq;
    __device__ __forceinline__ void pre(const Unit& u, int wr, int fr, float (&pv)[8]) const {
        const int row0 = u.pm * BM + wr * 64 + fr;
#pragma unroll
        for (int i = 0; i < 8; ++i) pv[i] = ssq[row0 + (i >> 2) * HALF + (i & 3) * 16];
    }
    __device__ __forceinline__ void operator()(const f32x4 (&acc)[2][2][4][2], const Unit& u, int wr, int wc, int fr, int fq, const float (&pv)[8]) const {
        const int row0 = u.pm * BM + wr * 64 + fr, col0 = u.pn * HALF + wc * 32 + 8 * fq;
#pragma unroll
        for (int ai = 0; ai < 2; ++ai)
#pragma unroll
            for (int m = 0; m < 4; ++m) { const int row = row0 + ai * HALF + m * 16; const float rs = __builtin_amdgcn_rsqf(pv[ai * 4 + m] * (1.f / DM) + EPS);
                float hv[8];
#pragma unroll
                for (int n = 0; n < 2; ++n)
#pragma unroll
                    for (int j = 0; j < 4; ++j) { const float g = acc[ai][0][m][n][j] * rs, uu = acc[ai][1][m][n][j] * rs;
                        const float e = __builtin_amdgcn_exp2f(-g * LOG2E); hv[n * 4 + j] = g * uu * __builtin_amdgcn_rcpf(1.f + e); }
                u32x4 w; w.x = cvtpk(hv[0], hv[1]); w.y = cvtpk(hv[2], hv[3]); w.z = cvtpk(hv[4], hv[5]); w.w = cvtpk(hv[6], hv[7]);
                *(u32x4*)(H + (size_t)row * DFF + col0) = w; }
    }
};
struct EpiResidual {
    static constexpr bool PERM = true;
    bf16_t* xb; float* ssq;
    __device__ __forceinline__ void pre(const Unit&, int, int, float (&)[8]) const {}
    __device__ __forceinline__ void operator()(const f32x4 (&acc)[2][2][4][2], const Unit& u, int wr, int wc, int fr, int fq, const float (&)[8]) const {
        const int row0 = u.pm * BM + wr * 64 + fr, col0 = u.pn * BM + wc * 32 + 8 * fq;
#pragma unroll
        for (int ai = 0; ai < 2; ++ai)
#pragma unroll
            for (int m = 0; m < 4; ++m) { const int row = row0 + ai * HALF + m * 16; bf16_t* rowp = xb + (size_t)row * DM + col0; float s = 0.f;
                u32x4 raw[2];
#pragma unroll
                for (int bj = 0; bj < 2; ++bj) raw[bj] = *(const u32x4*)(rowp + bj * HALF);
#pragma unroll
                for (int bj = 0; bj < 2; ++bj) { const f32x4 a0 = acc[ai][bj][m][0], a1 = acc[ai][bj][m][1]; const u32x4 r = raw[bj];
                    const float x0 = __builtin_bit_cast(float, r.x << 16) + a0[0], x1 = __builtin_bit_cast(float, r.x & 0xffff0000u) + a0[1];
                    const float x2 = __builtin_bit_cast(float, r.y << 16) + a0[2], x3 = __builtin_bit_cast(float, r.y & 0xffff0000u) + a0[3];
                    const float x4 = __builtin_bit_cast(float, r.z << 16) + a1[0], x5 = __builtin_bit_cast(float, r.z & 0xffff0000u) + a1[1];
                    const float x6 = __builtin_bit_cast(float, r.w << 16) + a1[2], x7 = __builtin_bit_cast(float, r.w & 0xffff0000u) + a1[3];
                    u32x4 w; w.x = cvtpk(x0, x1); w.y = cvtpk(x2, x3); w.z = cvtpk(x4, x5); w.w = cvtpk(x6, x7);
                    *(u32x4*)(rowp + bj * HALF) = w;
                    s += ((x0 * x0 + x1 * x1) + (x2 * x2 + x3 * x3)) + ((x4 * x4 + x5 * x5) + (x6 * x6 + x7 * x7)); }
                s += __shfl_xor(s, 16); s += __shfl_xor(s, 32);
                if (fq == 0) atomicAdd(ssq + row, s); }
    }
};

template <class Epi>
__device__ __forceinline__ void gemm_phase(LAS unsigned char* lds, const Gemm g, const StaticOrder& S, const Epi& E, const int wave_id) {
    int tid = threadIdx.x; asm volatile("" : "+v"(tid));
    const int wid = __builtin_amdgcn_readfirstlane(tid >> 6), lane = tid & 63, wr = wid >> 2, wc = wid & 3, fr = lane & 15, fq = lane >> 4;
    const int K = g.K, nt = K / BK;
    unsigned voffA[2], voffB[2];
#pragma unroll
    for (int i = 0; i < 2; ++i) { int R, C; stage_rc(tid * 16 + i * 8192, R, C); const int Rb = Epi::PERM ? ((R & ~31) + perm32(R & 31)) : R;
        voffA[i] = (unsigned)(R * K + C) * 2u; voffB[i] = (unsigned)(Rb * K + C) * 2u; }
    const size_t kstep = (size_t)(BK * 2);
    const size_t hstep = (size_t)HALF * K * 2;
    const size_t tstep = 2 * hstep;
    const unsigned ldsw = (unsigned)wid * 1024u;
    const int aoff = lds_byte(wr * 64 + fr, fq * 8), boff = lds_byte(wc * 32 + fr, fq * 8);
#define PG8_SA(b, h) (((b) * 2 + (h)) * HTB)
#define PG8_SB(b, h) ((4 + (b) * 2 + (h)) * HTB)
#define PG8_STAGE(bufoff, gbase, voff) do { _Pragma("unroll") for (int _i = 0; _i < 2; ++_i) \
        __builtin_amdgcn_global_load_lds((const unsigned*)((const char*)(gbase) + (voff)[_i]), (LAS unsigned*)(lds + (bufoff) + ldsw + _i * 8192), 16, 0, 0); } while (0)
#define PG8_LDA(dst, b, h) do { _Pragma("unroll") for (int m = 0; m < 4; ++m) _Pragma("unroll") for (int k = 0; k < 2; ++k) dst[m][k] = *(const LAS bf16x8*)(lds + PG8_SA(b, h) + aoff + m * 2048 + k * 1024); } while (0)
#define PG8_LDB(dst, b, h) do { _Pragma("unroll") for (int n = 0; n < 2; ++n) _Pragma("unroll") for (int k = 0; k < 2; ++k) dst[n][k] = *(const LAS bf16x8*)(lds + PG8_SB(b, h) + boff + n * 2048 + k * 1024); } while (0)
#define PG8_MMA(ai, bj, At, Bt) do { __builtin_amdgcn_s_setprio(1); _Pragma("unroll") for (int m = 0; m < 4; ++m) _Pragma("unroll") for (int n = 0; n < 2; ++n) _Pragma("unroll") for (int k = 0; k < 2; ++k) \
        acc[ai][bj][m][n] = __builtin_amdgcn_mfma_f32_16x16x32_bf16(Bt[n][k], At[m][k], acc[ai][bj][m][n], 0, 0, 0); __builtin_amdgcn_s_setprio(0); } while (0)
#define PG8_WAIT_V(n) asm volatile("s_waitcnt vmcnt(" #n ")" ::: "memory")
#define PG8_WAIT_L(n) asm volatile("s_waitcnt lgkmcnt(" #n ")" ::: "memory")
#define PG8_BAR __builtin_amdgcn_s_barrier()
#define PG8_SCHED __builtin_amdgcn_sched_barrier(0)
    Unit cur, nxt; int ui = 0;
    if (!S.next(0, cur)) return;
    f32x4 acc[2][2][4][2];
#pragma unroll
    for (int a = 0; a < 2; ++a)
#pragma unroll
        for (int b = 0; b < 2; ++b)
#pragma unroll
            for (int m = 0; m < 4; ++m)
#pragma unroll
                for (int n = 0; n < 2; ++n) acc[a][b][m][n] = (f32x4){0.f, 0.f, 0.f, 0.f};
    bf16x8 At[4][2], B0[2][2], B1[2][2];
    float epre[8] = {0.f, 0.f, 0.f, 0.f, 0.f, 0.f, 0.f, 0.f};
    const char* cA = (const char*)g.A + (size_t)cur.pm * tstep; const char* cB = (const char*)g.Bt + (size_t)cur.pn * tstep;
    PG8_STAGE(PG8_SB(0, 0), cB, voffB); PG8_STAGE(PG8_SB(0, 1), cB + hstep, voffB); PG8_STAGE(PG8_SA(0, 0), cA, voffA); PG8_STAGE(PG8_SA(0, 1), cA + hstep, voffA);
    if (wr == 1) PG8_BAR;
    PG8_WAIT_V(2); PG8_BAR;
    PG8_STAGE(PG8_SB(1, 0), cB + kstep, voffB); PG8_STAGE(PG8_SA(1, 0), cA + kstep, voffA); PG8_STAGE(PG8_SB(1, 1), cB + hstep + kstep, voffB);
    PG8_WAIT_V(6); PG8_BAR;
    for (;;) {
        const bool has_next = S.next(ui + 1, nxt);
        const char* nA = has_next ? (const char*)g.A + (size_t)nxt.pm * tstep : cA; const char* nB = has_next ? (const char*)g.Bt + (size_t)nxt.pn * tstep : cB;
        for (int t = 0; t < nt; t += 2) {
            const bool last = (t == nt - 2);
            if (last) E.pre(cur, wr, fr, epre);
            const char* a1 = cA + (size_t)(t + 1) * kstep;
            const char* a2 = last ? nA : cA + (size_t)(t + 2) * kstep; const char* b2 = last ? nB : cB + (size_t)(t + 2) * kstep;
            const char* a3 = a2 + kstep; const char* b3 = b2 + kstep;
            PG8_LDB(B0, 0, 0); PG8_LDB(B1, 0, 1); PG8_SCHED; PG8_LDA(At, 0, 0); PG8_STAGE(PG8_SA(1, 1), a1 + hstep, voffA);
            PG8_WAIT_V(8); PG8_WAIT_L(0); PG8_BAR; PG8_MMA(0, 0, At, B0); PG8_MMA(0, 1, At, B1); PG8_BAR; PG8_SCHED;
            PG8_LDA(At, 0, 1); PG8_STAGE(PG8_SB(0, 0), b2, voffB); PG8_STAGE(PG8_SB(0, 1), b2 + hstep, voffB); PG8_STAGE(PG8_SA(0, 0), a2, voffA);
            PG8_WAIT_V(8); PG8_WAIT_L(0); PG8_BAR; PG8_MMA(1, 0, At, B0); PG8_MMA(1, 1, At, B1); PG8_BAR; PG8_SCHED;
            PG8_LDB(B0, 1, 0); PG8_LDB(B1, 1, 1); PG8_SCHED; PG8_LDA(At, 1, 0); PG8_STAGE(PG8_SA(0, 1), a2 + hstep, voffA);
            PG8_WAIT_V(8); PG8_WAIT_L(0); PG8_BAR; PG8_MMA(0, 0, At, B0); PG8_MMA(0, 1, At, B1); PG8_BAR; PG8_SCHED;
            PG8_LDA(At, 1, 1); PG8_STAGE(PG8_SB(1, 0), b3, voffB); PG8_STAGE(PG8_SB(1, 1), b3 + hstep, voffB); PG8_STAGE(PG8_SA(1, 0), a3, voffA);
            PG8_WAIT_V(8); PG8_WAIT_L(0); PG8_BAR; PG8_MMA(1, 0, At, B0); PG8_MMA(1, 1, At, B1); PG8_BAR; PG8_SCHED;
        }
        if (wr == 0) PG8_BAR;
        E(acc, cur, wr, wc, fr, fq, epre);
        if (!has_next) break;
#pragma unroll
        for (int a = 0; a < 2; ++a)
#pragma unroll
            for (int b = 0; b < 2; ++b)
#pragma unroll
                for (int m = 0; m < 4; ++m)
#pragma unroll
                    for (int n = 0; n < 2; ++n) acc[a][b][m][n] = (f32x4){0.f, 0.f, 0.f, 0.f};
        cur = nxt; cA = nA; cB = nB; ++ui;
        if (wr == 1) PG8_BAR;
    }
    PG8_WAIT_V(0);
    PG8_BAR;
#undef PG8_SA
#undef PG8_SB
#undef PG8_STAGE
#undef PG8_LDA
#undef PG8_LDB
#undef PG8_MMA
#undef PG8_WAIT_V
#undef PG8_WAIT_L
#undef PG8_BAR
#undef PG8_SCHED
}
}

__device__ __forceinline__ void qkt(f32x16& p0, f32x16& p1, LAS const unsigned char* kslot, const bf16x8 (&qr)[4], int r32, int hi) {
    p0 = (f32x16){}; p1 = (f32x16){};
#pragma unroll
    for (int d0 = 0; d0 < 4; ++d0) {
        LAS const unsigned char* kb = kslot + (2 * d0 + hi) * 1024 + ((r32 ^ (2 * d0 + hi)) * 16); asm volatile("" : "+v"(kb));
        const bf16x8 b0 = *(LAS const bf16x8*)(kb);
        const bf16x8 b1 = *(LAS const bf16x8*)(kb + 512);
        p0 = __builtin_amdgcn_mfma_f32_32x32x16_bf16(b0, qr[d0], p0, 0, 0, 0);
        p1 = __builtin_amdgcn_mfma_f32_32x32x16_bf16(b1, qr[d0], p1, 0, 0, 0);
    }
}
__device__ __forceinline__ s16x4 vtr(LAS const unsigned char* p) { return __builtin_bit_cast(s16x4, __builtin_amdgcn_ds_read_tr16_b64_v4i16((LAS s16x4*)p)); }
__device__ __forceinline__ void pv(f32x16 (&o)[2], LAS const unsigned char* vp, const bf16x8 (&pa)[4]) {
    asm volatile("" : "+v"(vp));
#pragma unroll
    for (int d0 = 0; d0 < 2; ++d0)
#pragma unroll
        for (int ks = 0; ks < 4; ++ks) {
            const s16x4 lo = vtr(vp + d0 * 4096 + ks * 1024), hh = vtr(vp + d0 * 4096 + ks * 1024 + 512);
            const bf16x8 vf = (bf16x8){lo[0], lo[1], lo[2], lo[3], hh[0], hh[1], hh[2], hh[3]};
            o[d0] = __builtin_amdgcn_mfma_f32_32x32x16_bf16(pa[ks], vf, o[d0], 0, 0, 0);
        }
}
struct ModNone { __device__ __forceinline__ void apply(f32x16&, f32x16&, int, int) const {} };
struct ModNA {
    int kcs; LAS const float* tl;
    __device__ __forceinline__ void apply(f32x16& p0, f32x16& p1, int, int) const {
#pragma unroll
        for (int r = 0; r < 16; ++r) { constexpr int dummy = 0; (void)dummy; const int cr = (r & 3) + 8 * (r >> 2);
            { const float v = p0[r] + tl[cr]; p0[r] = ((unsigned)(cr + kcs) < 16u) ? v : -INFINITY; }
            { const float v = p1[r] + tl[cr + 32]; p1[r] = ((unsigned)(cr + 32 + kcs) < 16u) ? v : -INFINITY; } }
    }
};
struct ModNAP {
    int kcs; LAS const float* tl; int U[8], C8[8];
    __device__ __forceinline__ void apply(f32x16& p0, f32x16& p1, int, int) const {
#pragma unroll
        for (int r = 0; r < 16; ++r) { const int gq = r >> 2, w = r & 3;
            { const float v = p0[r] + tl[U[gq] + w]; p0[r] = ((unsigned)(C8[gq] + w + kcs) < 16u) ? v : -INFINITY; }
            { const float v = p1[r] + tl[U[gq + 4] + w]; p1[r] = ((unsigned)(C8[gq + 4] + w + kcs) < 16u) ? v : -INFINITY; } }
    }
};
struct ModDil {
    float af, strf, limf, slope2, tqf, tqmS; bool inb;
    __device__ __forceinline__ void apply(f32x16& p0, f32x16& p1, int, int) const {
        if (inb) {
#pragma unroll
            for (int r = 0; r < 16; ++r) { const float cr = (float)((r & 3) + 8 * (r >> 2));
                { const float d = __builtin_fmaf(-cr, strf, af); const float v = __builtin_fmaf(-slope2, __builtin_fabsf(d), p0[r]); p0[r] = (__builtin_fabsf(d) <= limf) ? v : -INFINITY; }
                { const float d = __builtin_fmaf(-(cr + 32.f), strf, af); const float v = __builtin_fmaf(-slope2, __builtin_fabsf(d), p1[r]); p1[r] = (__builtin_fabsf(d) <= limf) ? v : -INFINITY; } }
        } else {
#pragma unroll
            for (int r = 0; r < 16; ++r) { const float cr = (float)((r & 3) + 8 * (r >> 2));
                { const float d = __builtin_fmaf(-cr, strf, af); const float v = __builtin_fmaf(-slope2, __builtin_fabsf(d), p0[r]); p0[r] = ((__builtin_fabsf(d) <= limf) && (d <= tqf) && (d > tqmS)) ? v : -INFINITY; }
                { const float d = __builtin_fmaf(-(cr + 32.f), strf, af); const float v = __builtin_fmaf(-slope2, __builtin_fabsf(d), p1[r]); p1[r] = ((__builtin_fabsf(d) <= limf) && (d <= tqf) && (d > tqmS)) ? v : -INFINITY; } }
        }
    }
};
template <class Mod>
__device__ __forceinline__ void flash_step(LAS const unsigned char* kslot, LAS const unsigned char* vslot, const bf16x8 (&qr)[4], f32x16 (&o)[2], float& m, float& l, LAS float* wsf, int lane, const Mod& mod) {
    const int r32 = lane & 31, hi = lane >> 5;
    f32x16 p0, p1; qkt(p0, p1, kslot, qr, r32, hi);
    mod.apply(p0, p1, r32, hi);
    float rm = fmaxf(p0[0], p1[0]);
#pragma unroll
    for (int r = 1; r < 16; ++r) rm = fmaxf(rm, fmaxf(p0[r], p1[r]));
    rm = fmaxf(rm, __shfl_xor(rm, 32));
    const float mn = fmaxf(m, rm); const float alpha = __builtin_amdgcn_exp2f(m - mn); m = mn;
    float s = 0.f;
#pragma unroll
    for (int r = 0; r < 16; ++r) { p0[r] = __builtin_amdgcn_exp2f(p0[r] - mn); p1[r] = __builtin_amdgcn_exp2f(p1[r] - mn); s += p0[r] + p1[r]; }
    l = l * alpha + s;
    { LAS float* ww = wsf + r32; asm volatile("" : "+v"(ww)); if (hi == 0) *ww = alpha; }
    asm volatile("" ::: "memory");
    LAS const float* wr_ = wsf + 4 * hi; asm volatile("" : "+v"(wr_));
#pragma unroll
    for (int k = 0; k < 4; ++k) { const f32x4 a = *(LAS const f32x4*)(wr_ + 8 * k);
#pragma unroll
        for (int j = 0; j < 4; ++j) { o[0][4 * k + j] *= a[j]; o[1][4 * k + j] *= a[j]; } }
    bf16x8 pa[4];
    { u32x4 w;
      w = (u32x4){cvtpk(p0[0], p0[1]), cvtpk(p0[2], p0[3]), cvtpk(p0[4], p0[5]), cvtpk(p0[6], p0[7])}; pa[0] = __builtin_bit_cast(bf16x8, w);
      w = (u32x4){cvtpk(p0[8], p0[9]), cvtpk(p0[10], p0[11]), cvtpk(p0[12], p0[13]), cvtpk(p0[14], p0[15])}; pa[1] = __builtin_bit_cast(bf16x8, w);
      w = (u32x4){cvtpk(p1[0], p1[1]), cvtpk(p1[2], p1[3]), cvtpk(p1[4], p1[5]), cvtpk(p1[6], p1[7])}; pa[2] = __builtin_bit_cast(bf16x8, w);
      w = (u32x4){cvtpk(p1[8], p1[9]), cvtpk(p1[10], p1[11]), cvtpk(p1[12], p1[13]), cvtpk(p1[14], p1[15])}; pa[3] = __builtin_bit_cast(bf16x8, w); }
    const int vb = ((lane >> 4) & 1) * 32 + (lane & 3) * 8 + (4 * hi + ((lane & 15) >> 2)) * 64;
    pv(o, vslot + vb, pa);
}
template <class Mod>
__device__ __forceinline__ void flash_scores(LAS const unsigned char* kslot, const bf16x8 (&qr)[4], f32x16 (&o)[2], float& m, float& l, LAS float* wsf, int lane, const Mod& mod, bf16x8 (&pa)[4]) {
    const int r32 = lane & 31, hi = lane >> 5;
    f32x16 p0, p1; qkt(p0, p1, kslot, qr, r32, hi);
    mod.apply(p0, p1, r32, hi);
    float rm = fmaxf(p0[0], p1[0]);
#pragma unroll
    for (int r = 1; r < 16; ++r) rm = fmaxf(rm, fmaxf(p0[r], p1[r]));
    rm = fmaxf(rm, __shfl_xor(rm, 32));
    const float mn = fmaxf(m, rm); const float alpha = __builtin_amdgcn_exp2f(m - mn); m = mn;
    float s = 0.f;
#pragma unroll
    for (int r = 0; r < 16; ++r) { p0[r] = __builtin_amdgcn_exp2f(p0[r] - mn); p1[r] = __builtin_amdgcn_exp2f(p1[r] - mn); s += p0[r] + p1[r]; }
    l = l * alpha + s;
    { LAS float* ww = wsf + r32; asm volatile("" : "+v"(ww)); if (hi == 0) *ww = alpha; }
    asm volatile("" ::: "memory");
    LAS const float* wr_ = wsf + 4 * hi; asm volatile("" : "+v"(wr_));
#pragma unroll
    for (int k = 0; k < 4; ++k) { const f32x4 a = *(LAS const f32x4*)(wr_ + 8 * k);
#pragma unroll
        for (int j = 0; j < 4; ++j) { o[0][4 * k + j] *= a[j]; o[1][4 * k + j] *= a[j]; } }
    { u32x4 w;
      w = (u32x4){cvtpk(p0[0], p0[1]), cvtpk(p0[2], p0[3]), cvtpk(p0[4], p0[5]), cvtpk(p0[6], p0[7])}; pa[0] = __builtin_bit_cast(bf16x8, w);
      w = (u32x4){cvtpk(p0[8], p0[9]), cvtpk(p0[10], p0[11]), cvtpk(p0[12], p0[13]), cvtpk(p0[14], p0[15])}; pa[1] = __builtin_bit_cast(bf16x8, w);
      w = (u32x4){cvtpk(p1[0], p1[1]), cvtpk(p1[2], p1[3]), cvtpk(p1[4], p1[5]), cvtpk(p1[6], p1[7])}; pa[2] = __builtin_bit_cast(bf16x8, w);
      w = (u32x4){cvtpk(p1[8], p1[9]), cvtpk(p1[10], p1[11]), cvtpk(p1[12], p1[13]), cvtpk(p1[14], p1[15])}; pa[3] = __builtin_bit_cast(bf16x8, w); }
    asm volatile("" : "+v"(pa[0]), "+v"(pa[1]), "+v"(pa[2]), "+v"(pa[3]) :: "memory");
}
__device__ __forceinline__ void pv_lane(f32x16 (&o)[2], LAS const unsigned char* vslot, const bf16x8 (&pa)[4], int lane) {
    const int hi = lane >> 5;
    const int vb = ((lane >> 4) & 1) * 32 + (lane & 3) * 8 + (4 * hi + ((lane & 15) >> 2)) * 64;
    pv(o, vslot + vb, pa);
}
__device__ __forceinline__ float max3f(float a, float b, float c) { float r; asm("v_max3_f32 %0, %1, %2, %3" : "=v"(r) : "v"(a), "v"(b), "v"(c)); return r; }
__device__ __forceinline__ float rowmax32(const f32x16& p0, const f32x16& p1) {
    float a = max3f(p0[0], p0[1], p1[0]), b = max3f(p0[2], p0[3], p1[1]); a = max3f(a, p1[2], p1[3]);
#pragma unroll
    for (int r = 4; r < 16; r += 4) { a = max3f(a, p0[r], p0[r + 1]); b = max3f(b, p0[r + 2], p0[r + 3]); a = max3f(a, p1[r], p1[r + 1]); b = max3f(b, p1[r + 2], p1[r + 3]); }
    return fmaxf(a, b);
}
constexpr float THRL = 8.f;
__device__ __forceinline__ void qkt2(f32x16& p0, f32x16& p1, LAS const unsigned char* kslot, const bf16x8 (&qr)[4], const f32x16& negm, int r32, int hi) {
#pragma unroll
    for (int d0 = 0; d0 < 4; ++d0) {
        LAS const unsigned char* kb = kslot + (2 * d0 + hi) * 1024 + ((r32 ^ (2 * d0 + hi)) * 16); asm volatile("" : "+v"(kb));
        const bf16x8 b0 = *(LAS const bf16x8*)(kb);
        const bf16x8 b1 = *(LAS const bf16x8*)(kb + 512);
        if (d0 == 0) { p0 = __builtin_amdgcn_mfma_f32_32x32x16_bf16(b0, qr[0], negm, 0, 0, 0); p1 = __builtin_amdgcn_mfma_f32_32x32x16_bf16(b1, qr[0], negm, 0, 0, 0); }
        else { p0 = __builtin_amdgcn_mfma_f32_32x32x16_bf16(b0, qr[d0], p0, 0, 0, 0); p1 = __builtin_amdgcn_mfma_f32_32x32x16_bf16(b1, qr[d0], p1, 0, 0, 0); }
    }
}
template <bool HASNEXT, class Mod>
__device__ __forceinline__ void softmax2(f32x16& p0, f32x16& p1, f32x16 (&o)[2], f32x16& negm, float& mref, float& l, LAS float* wsf, int lane, const Mod& mod, bf16x8 (&pa)[4], f32x16& n0, f32x16& n1) {
    const int r32 = lane & 31, hi = lane >> 5;
    mod.apply(p0, p1, r32, hi);
    float rm = rowmax32(p0, p1);
    if (__builtin_expect(__any(rm > THRL), 0)) {
        rm = fmaxf(rm, __shfl_xor(rm, 32));
        const float dl = fmaxf(rm, 0.f);
        mref += dl;
#pragma unroll
        for (int r = 0; r < 16; ++r) { p0[r] -= dl; p1[r] -= dl; }
        if (HASNEXT) {
#pragma unroll
            for (int r = 0; r < 16; ++r) { n0[r] -= dl; n1[r] -= dl; } }
#pragma unroll
        for (int r = 0; r < 16; ++r) negm[r] = -mref;
        const float f = __builtin_amdgcn_exp2f(-dl); l *= f;
        { LAS float* ww = wsf + r32; asm volatile("" : "+v"(ww)); if (hi == 0) *ww = f; }
        asm volatile("" ::: "memory");
        LAS const float* wr_ = wsf + 4 * hi; asm volatile("" : "+v"(wr_));
#pragma unroll
        for (int k = 0; k < 4; ++k) { const f32x4 a = *(LAS const f32x4*)(wr_ + 8 * k);
#pragma unroll
            for (int j = 0; j < 4; ++j) { o[0][4 * k + j] *= a[j]; o[1][4 * k + j] *= a[j]; } }
    }
    float s = 0.f;
#pragma unroll
    for (int r = 0; r < 16; ++r) { p0[r] = __builtin_amdgcn_exp2f(p0[r]); p1[r] = __builtin_amdgcn_exp2f(p1[r]); s += p0[r] + p1[r]; }
    l += s;
    { u32x4 w;
      w = (u32x4){cvtpk(p0[0], p0[1]), cvtpk(p0[2], p0[3]), cvtpk(p0[4], p0[5]), cvtpk(p0[6], p0[7])}; pa[0] = __builtin_bit_cast(bf16x8, w);
      w = (u32x4){cvtpk(p0[8], p0[9]), cvtpk(p0[10], p0[11]), cvtpk(p0[12], p0[13]), cvtpk(p0[14], p0[15])}; pa[1] = __builtin_bit_cast(bf16x8, w);
      w = (u32x4){cvtpk(p1[0], p1[1]), cvtpk(p1[2], p1[3]), cvtpk(p1[4], p1[5]), cvtpk(p1[6], p1[7])}; pa[2] = __builtin_bit_cast(bf16x8, w);
      w = (u32x4){cvtpk(p1[8], p1[9]), cvtpk(p1[10], p1[11]), cvtpk(p1[12], p1[13]), cvtpk(p1[14], p1[15])}; pa[3] = __builtin_bit_cast(bf16x8, w); }
}
__device__ __forceinline__ void flash_finish(f32x16 (&o)[2], float l, LAS float* wsf, LAS unsigned char* stg, bf16_t* Obase, size_t qstride, int lane) {
    asm volatile("" : "+v"(lane));
    const int r32 = lane & 31, hi = lane >> 5;
    l += __shfl_xor(l, 32);
    { LAS float* ww = wsf + 32 + r32; asm volatile("" : "+v"(ww)); if (hi == 0) *ww = l; }
    asm volatile("" ::: "memory");
    LAS const float* wr_ = wsf + 32 + 4 * hi; asm volatile("" : "+v"(wr_));
    LAS bf16_t* st = (LAS bf16_t*)stg + (4 * hi) * 64 + r32; asm volatile("" : "+v"(st));
#pragma unroll
    for (int k = 0; k < 4; ++k) { const f32x4 a = *(LAS const f32x4*)(wr_ + 8 * k);
#pragma unroll
        for (int j = 0; j < 4; ++j) { const float rl = __builtin_amdgcn_rcpf(a[j]);
            st[(j + 8 * k) * 64] = (bf16_t)(cvtpk(o[0][4 * k + j] * rl, 0.f) & 0xffffu);
            st[(j + 8 * k) * 64 + 32] = (bf16_t)(cvtpk(o[1][4 * k + j] * rl, 0.f) & 0xffffu); } }
    asm volatile("" ::: "memory");
    LAS const bf16_t* sr = (LAS const bf16_t*)stg + (lane >> 3) * 64 + (lane & 7) * 8; asm volatile("" : "+v"(sr));
    bf16_t* op = Obase + (size_t)(lane >> 3) * qstride + (lane & 7) * 8;
#pragma unroll
    for (int i = 0; i < 4; ++i) { const u32x4 v = *(LAS const u32x4*)(sr + i * 8 * 64);
        *(u32x4*)(op + (size_t)(i * 8) * qstride) = v; }
}

__device__ __forceinline__ void flash_finish_c(f32x16 (&o)[2], float l, float mref, LAS float* wsf, LAS unsigned char* stg, bf16_t* Obase, size_t qstride, int lane, float* lse0, int lstep, bool merge) {
    asm volatile("" : "+v"(lane));
    const int r32 = lane & 31, hi = lane >> 5;
    float* lsep = lse0 + (size_t)r32 * lstep;
    l += __shfl_xor(l, 32);
    const float lse2 = mref + __builtin_amdgcn_logf(l);
    float fa = 0.f, rl = __builtin_amdgcn_rcpf(l);
    if (merge) { const float lse1 = *lsep; const float M = fmaxf(lse1, lse2); const float w1 = __builtin_amdgcn_exp2f(lse1 - M), w2 = __builtin_amdgcn_exp2f(lse2 - M); const float inv = __builtin_amdgcn_rcpf(w1 + w2); fa = w1 * inv; rl = w2 * inv * rl; }
    else if (hi == 0) *lsep = lse2;
    { LAS float* ww = wsf + r32; asm volatile("" : "+v"(ww)); if (hi == 0) { ww[0] = fa; ww[32] = rl; } }
    asm volatile("" ::: "memory");
    LAS const float* wr_ = wsf + 32 + 4 * hi; asm volatile("" : "+v"(wr_));
    LAS bf16_t* st = (LAS bf16_t*)stg + (4 * hi) * 64 + r32; asm volatile("" : "+v"(st));
#pragma unroll
    for (int k = 0; k < 4; ++k) { const f32x4 a = *(LAS const f32x4*)(wr_ + 8 * k);
#pragma unroll
        for (int j = 0; j < 4; ++j) {
            st[(j + 8 * k) * 64] = (bf16_t)(cvtpk(o[0][4 * k + j] * a[j], 0.f) & 0xffffu);
            st[(j + 8 * k) * 64 + 32] = (bf16_t)(cvtpk(o[1][4 * k + j] * a[j], 0.f) & 0xffffu); } }
    asm volatile("" ::: "memory");
    LAS const bf16_t* sr = (LAS const bf16_t*)stg + (lane >> 3) * 64 + (lane & 7) * 8; asm volatile("" : "+v"(sr));
    LAS const float* fr_ = wsf + (lane >> 3); asm volatile("" : "+v"(fr_));
    bf16_t* op = Obase + (size_t)(lane >> 3) * qstride + (lane & 7) * 8;
#pragma unroll
    for (int i = 0; i < 4; ++i) { u32x4 v = *(LAS const u32x4*)(sr + i * 8 * 64);
        if (merge) { const float f = fr_[i * 8]; const u32x4 g = *(const u32x4*)(op + (size_t)(i * 8) * qstride);
            v.x = cvtpk(__builtin_fmaf(f, __builtin_bit_cast(float, g.x << 16), __builtin_bit_cast(float, v.x << 16)), __builtin_fmaf(f, __builtin_bit_cast(float, g.x & 0xffff0000u), __builtin_bit_cast(float, v.x & 0xffff0000u)));
            v.y = cvtpk(__builtin_fmaf(f, __builtin_bit_cast(float, g.y << 16), __builtin_bit_cast(float, v.y << 16)), __builtin_fmaf(f, __builtin_bit_cast(float, g.y & 0xffff0000u), __builtin_bit_cast(float, v.y & 0xffff0000u)));
            v.z = cvtpk(__builtin_fmaf(f, __builtin_bit_cast(float, g.z << 16), __builtin_bit_cast(float, v.z << 16)), __builtin_fmaf(f, __builtin_bit_cast(float, g.z & 0xffff0000u), __builtin_bit_cast(float, v.z & 0xffff0000u)));
            v.w = cvtpk(__builtin_fmaf(f, __builtin_bit_cast(float, g.w << 16), __builtin_bit_cast(float, v.w << 16)), __builtin_fmaf(f, __builtin_bit_cast(float, g.w & 0xffff0000u), __builtin_bit_cast(float, v.w & 0xffff0000u))); }
        *(u32x4*)(op + (size_t)(i * 8) * qstride) = v; }
}

#define XB_TMO      128
#define XB_XCNT(j)  (256  + 64 * (j))
#define XB_XSUB(j)  (1280 + 64 * (j))
#define XB_XGEN(j)  (2304 + 64 * (j))
#define XB_TOP      3328
#define XB_TOPGEN   3392
#define XCD_BAR_WORDS 3456
#define XB_SPIN_CAP (1u << 22)
__device__ __forceinline__ unsigned xb_ld(unsigned* p)              { return __hip_atomic_load(p, __ATOMIC_RELAXED, __HIP_MEMORY_SCOPE_AGENT); }
__device__ __forceinline__ unsigned xb_add(unsigned* p, unsigned v) { return __hip_atomic_fetch_add(p, v, __ATOMIC_RELAXED, __HIP_MEMORY_SCOPE_AGENT); }
__device__ __forceinline__ unsigned xb_xcc_id() { return (unsigned)__builtin_amdgcn_s_getreg((3 << 11) | 20) & 0xFu; }
#define XB_SPIN(cond, bar) do { unsigned _sp = 0; while (cond) { __builtin_amdgcn_s_sleep(1); \
    if ((++_sp & 255u) == 0u) { if (xb_ld(&(bar)[XB_TMO])) break; if (_sp > XB_SPIN_CAP) { atomicAdd(&(bar)[XB_TMO], 1u); break; } } } } while (0)
struct XcdBarrier { unsigned* bar; unsigned x; volatile LAS unsigned* st; };
__device__ __forceinline__ XcdBarrier xcd_barrier_post(unsigned* bar, volatile LAS unsigned* st) {
    XcdBarrier b; b.bar = bar; b.x = xb_xcc_id(); b.st = st;
    if (threadIdx.x == 0) (void)xb_add(&bar[XB_XCNT(b.x)], 1u);
    return b;
}
__device__ __forceinline__ void xcd_barrier_complete(unsigned* bar, unsigned x, unsigned& nloc, unsigned& nx) {
    const unsigned G = gridDim.x * gridDim.y * gridDim.z;
    unsigned sum, cnt, mine, sp = 0u;
    for (;;) {
        sum = 0u; cnt = 0u; mine = 0u;
#pragma unroll
        for (unsigned j = 0; j < 16; ++j) { const unsigned c = xb_ld(&bar[XB_XCNT(j)]); sum += c; cnt += (c > 0u) ? 1u : 0u; mine = (j == x) ? c : mine; }
        if (sum == G) break;
        __builtin_amdgcn_s_sleep(1);
        if ((++sp & 255u) == 0u) { if (xb_ld(&bar[XB_TMO])) break; if (sp > XB_SPIN_CAP) { atomicAdd(&bar[XB_TMO], 1u); break; } }
    }
    nloc = mine > 0u ? mine : 1u; nx = cnt > 0u ? cnt : 1u;
}
__device__ __forceinline__ void xcd_barrier(const XcdBarrier& b) {
    asm volatile("s_waitcnt vmcnt(0)" ::: "memory");
    __syncthreads();
    if (threadIdx.x == 0) {
        unsigned* bar = b.bar; asm volatile("" : "+s"(bar));
        __builtin_amdgcn_s_waitcnt(0);
        unsigned nloc = b.st[0], nx = b.st[1];
        if (nloc == 0u) { xcd_barrier_complete(bar, b.x, nloc, nx); b.st[0] = nloc; b.st[1] = nx; }
        const unsigned old = xb_add(&bar[XB_XSUB(b.x)], 1u);
        const unsigned gen = old / nloc;
        if (old + 1u == (gen + 1u) * nloc) {
            __builtin_amdgcn_fence(__ATOMIC_RELEASE, "agent");
            asm volatile("s_waitcnt vmcnt(0)" ::: "memory");
            const unsigned og = xb_add(&bar[XB_TOP], 1u);
            const unsigned tg = og / nx;
            if (og + 1u == (tg + 1u) * nx) xb_add(&bar[XB_TOPGEN], 1u);
            else XB_SPIN(xb_ld(&bar[XB_TOPGEN]) == tg, bar);
            __builtin_amdgcn_fence(__ATOMIC_ACQUIRE, "agent");
            xb_add(&bar[XB_XGEN(b.x)], 1u);
            asm volatile("s_waitcnt vmcnt(0)" ::: "memory");
        } else {
            XB_SPIN(xb_ld(&bar[XB_XGEN(b.x)]) == gen, bar);
            __builtin_amdgcn_fence(__ATOMIC_ACQUIRE, "agent");
            asm volatile("s_waitcnt vmcnt(0)" ::: "memory");
        }
    }
    __syncthreads();
}

__device__ __forceinline__ u32x4 prep_item(const u32x4 raw, const float* gn, const f32x2* rope, int pr, int pc, int cc, float sc) {
    float y[8]; y[0] = bf2f(raw.x & 0xffff); y[1] = bf2f(raw.x >> 16); y[2] = bf2f(raw.y & 0xffff); y[3] = bf2f(raw.y >> 16); y[4] = bf2f(raw.z & 0xffff); y[5] = bf2f(raw.z >> 16); y[6] = bf2f(raw.w & 0xffff); y[7] = bf2f(raw.w >> 16);
    float sq = 0.f;
#pragma unroll
    for (int j = 0; j < 8; ++j) sq += y[j] * y[j];
    sq += __shfl_xor(sq, 1); sq += __shfl_xor(sq, 2); sq += __shfl_xor(sq, 4);
    const float rn = __builtin_amdgcn_rsqf(sq * (1.f / 64.f) + EPS);
    const int pos = (cc >> 2) ? pc : pr; const f32x2* tb = rope + pos * 16 + (cc & 1) * 8; const bool first = (cc & 3) < 2;
    float ov[8];
#pragma unroll
    for (int j = 0; j < 8; ++j) { const float yy = y[j] * rn * gn[j]; const float py = __shfl_xor(yy, 2); const f32x2 cs = tb[j];
        ov[j] = (first ? (yy * cs.x - py * cs.y) : (py * cs.y + yy * cs.x)) * sc; }
    return (u32x4){cvtpk(ov[0], ov[1]), cvtpk(ov[2], ov[3]), cvtpk(ov[4], ov[5]), cvtpk(ov[6], ov[7])};
}

struct Params { const float* in[14]; float* out; unsigned char* ws; };

__device__ __forceinline__ void transpose_item(const float* W, int K, int N, bf16_t* WT, const float* gain, int mode, LAS float* scr, int item, int lane) {
    asm volatile("" : "+v"(lane));
    const int nblk = N / 32, kb = item / nblk, nb = item % nblk, k0 = 64 * kb, n0 = 32 * nb;
#pragma unroll 8
    for (int i = 0; i < 32; ++i) { const int kk = 2 * i + (lane >> 5); float w = __builtin_nontemporal_load(W + (size_t)(k0 + kk) * N + n0 + (lane & 31)); if (gain) w *= gain[k0 + kk]; scr[kk * 33 + (lane & 31)] = w; }
    int d0 = n0;
    if (mode == 1) { const int j = n0 < DFF ? n0 : n0 - DFF; d0 = 256 * (j >> 7) + (j & 127) + (n0 < DFF ? 0 : 128); }
    const int c = lane & 7;
#pragma unroll
    for (int j = 0; j < 4; ++j) { const int n = (lane >> 3) + 8 * j; const LAS float* s = scr + (8 * c) * 33 + n;
        u32x4 o; o.x = cvtpk(s[0 * 33], s[1 * 33]); o.y = cvtpk(s[2 * 33], s[3 * 33]); o.z = cvtpk(s[4 * 33], s[5 * 33]); o.w = cvtpk(s[6 * 33], s[7 * 33]);
        *(u32x4*)(WT + (size_t)(d0 + n) * K + k0 + 8 * c) = o; }
}

__global__ void __launch_bounds__(NTHREADS) fwd_megakernel(Params P) {
#define GAS __attribute__((address_space(1)))
#define KA(i) ((const float*)(const GAS float*)ka[(i)])
    extern __shared__ __attribute__((aligned(16))) unsigned char lds_raw[];
    cg::grid_group grid = cg::this_grid();
    LAS unsigned char* lds = (LAS unsigned char*)lds_raw;
    const int tid0 = threadIdx.x, wave = __builtin_amdgcn_readfirstlane(tid0 >> 6);
    const int G0 = gridDim.x, bx0 = blockIdx.x;
    const int vcu0 = (G0 % 8 == 0) ? (bx0 % 8) * (G0 / 8) + bx0 / 8 : bx0;
    LAS float* wsf = (LAS float*)(lds + WSF_OFF) + wave * 64;
    volatile LAS unsigned* bst = (volatile LAS unsigned*)(lds + PTAB_OFF);
    if (tid0 < 2) bst[tid0] = 0u;
    __syncthreads();
    XcdBarrier xbar = xcd_barrier_post((unsigned*)(P.ws + WS_BAR), bst);

    for (int ph = 0; ph <= 24; ++ph) {
        const __attribute__((address_space(4))) unsigned long long* ka = (const __attribute__((address_space(4))) unsigned long long*)__builtin_amdgcn_kernarg_segment_ptr(); asm volatile("" : "+s"(ka));
        unsigned char* ws = (unsigned char*)(GAS unsigned char*)ka[15];
        f32x2* rope = (f32x2*)(ws + WS_ROPE);
        float* ssq_all = (float*)(ws + WS_SSQ);
        bf16_t* QKV = (bf16_t*)(ws + WS_QKV); bf16_t* HB = (bf16_t*)(ws + WS_H); bf16_t* OB = (bf16_t*)(ws + WS_O);
        int G = G0, bx = bx0, vcu = vcu0; asm volatile("" : "+s"(G), "+s"(bx), "+s"(vcu));
        const int gw = vcu * NWAVES + wave, NGW = G * NWAVES;
        int tid = tid0; asm volatile("" : "+v"(tid));
        const int lane = tid & 63, r32 = lane & 31, hi = lane >> 5;
        const int c = ph / 12, s = ph % 12;
        const int S = (c == 0) ? 8192 : 4096, nb = RC / S;
        const float* xin = KA(c & 1);
        float* xout = ((float*)(GAS float*)ka[14]) + (size_t)(c & 1) * RC * DM;
        float* ssq = ssq_all + (size_t)(c & 1) * 5 * RC;
        bf16_t* XB = (bf16_t*)(ws + ((c & 1) ? WS_XB1 : WS_XB));
        if (s == 0) {
            if (ph == 0 && (PHM & 1)) {
                LAS float* scr = (LAS float*)(lds + wave * 16384);
                constexpr int I0 = 16 * (NE / 32), I1 = 16 * (DM / 32), I2 = 16 * (NO / 32), I3 = I1, I4 = 16 * (NGU / 32), I5 = I4, I6 = (DFF / 64) * (DM / 32), I7 = I6;
                constexpr int NIT = I0 + I1 + I2 + I3 + I4 + I5 + I6 + I7;
                for (int it = gw; it < NIT; it += NGW) {
                    int r = it;
                    if (r < I0) { transpose_item(KA(5), DM, NE, (bf16_t*)(ws + W_INE), KA(2), 0, scr, r, lane); continue; } r -= I0;
                    if (r < I1) { transpose_item(KA(9), DM, DM, (bf16_t*)(ws + W_OUTE), nullptr, 0, scr, r, lane); continue; } r -= I1;
                    if (r < I2) { transpose_item(KA(10), DM, NO, (bf16_t*)(ws + W_INO), KA(2) + DM, 0, scr, r, lane); continue; } r -= I2;
                    if (r < I3) { transpose_item(KA(11), DM, DM, (bf16_t*)(ws + W_OUTO), nullptr, 0, scr, r, lane); continue; } r -= I3;
                    if (r < I4) { transpose_item(KA(12), DM, NGU, (bf16_t*)(ws + W_GU0), KA(3), 1, scr, r, lane); continue; } r -= I4;
                    if (r < I5) { transpose_item(KA(12) + (size_t)DM * NGU, DM, NGU, (bf16_t*)(ws + W_GU1), KA(3) + DM, 1, scr, r, lane); continue; } r -= I5;
                    if (r < I6) { transpose_item(KA(13), DFF, DM, (bf16_t*)(ws + W_DN0), nullptr, 0, scr, r, lane); continue; } r -= I6;
                    transpose_item(KA(13) + (size_t)DFF * DM, DFF, DM, (bf16_t*)(ws + W_DN1), nullptr, 0, scr, r, lane);
                }
                const int gt = vcu * NTHREADS + tid;
                if (gt < 2048) { const int pos = gt >> 4, i = gt & 15; const float fr = __builtin_amdgcn_exp2f(-(float)i * (13.287712379549449f / 16.f)); const float ang = (float)pos * fr;
                    float sn, cs; sincosf(ang, &sn, &cs); rope[gt] = (f32x2){cs, sn}; }
            }
            if (c >= 1) {
                float* po = ((float*)(GAS float*)ka[14]) + (size_t)(c - 1) * RC * DM; const float* pq = ssq_all + (size_t)(c - 1) * 5 * RC + 4 * RC; const float* gf = KA(4);
                const bf16_t* xp = (const bf16_t*)(ws + (((c - 1) & 1) ? WS_XB1 : WS_XB));
                for (int row = gw; row < RC; row += NGW) { const float rs = __builtin_amdgcn_rsqf(pq[row] * (1.f / DM) + EPS);
#pragma unroll
                    for (int hf = 0; hf < 2; ++hf) { const u32x4 r = __builtin_nontemporal_load((const u32x4*)(xp + (size_t)row * DM + hf * 512 + lane * 8));
                        const f32x4 g0 = *(const f32x4*)(gf + hf * 512 + lane * 8), g1 = *(const f32x4*)(gf + hf * 512 + lane * 8 + 4);
                        f32x4 y0, y1;
                        y0[0] = __builtin_bit_cast(float, r.x << 16); y0[1] = __builtin_bit_cast(float, r.x & 0xffff0000u); y0[2] = __builtin_bit_cast(float, r.y << 16); y0[3] = __builtin_bit_cast(float, r.y & 0xffff0000u);
                        y1[0] = __builtin_bit_cast(float, r.z << 16); y1[1] = __builtin_bit_cast(float, r.z & 0xffff0000u); y1[2] = __builtin_bit_cast(float, r.w << 16); y1[3] = __builtin_bit_cast(float, r.w & 0xffff0000u);
                        f32x4* op = (f32x4*)(po + (size_t)row * DM + hf * 512 + lane * 8);
                        __builtin_nontemporal_store(y0 * rs * g0, op); __builtin_nontemporal_store(y1 * rs * g1, op + 1); } }
            }
            if (c < 2) {
                for (int row = gw; row < RC; row += NGW) { const f32x4* xr = (const f32x4*)(xin + (size_t)row * DM) + lane; f32x4 v[4]; float sq = 0.f;
#pragma unroll
                    for (int j = 0; j < 4; ++j) { v[j] = __builtin_nontemporal_load(xr + 64 * j); sq += (v[j].x * v[j].x + v[j].y * v[j].y) + (v[j].z * v[j].z + v[j].w * v[j].w); }
                    sq = wave_sum(sq); u32x2* o8 = (u32x2*)(XB + (size_t)row * DM) + lane;
#pragma unroll
                    for (int j = 0; j < 4; ++j) o8[64 * j] = (u32x2){cvtpk(v[j].x, v[j].y), cvtpk(v[j].z, v[j].w)};
                    if (lane < 5) ssq[(size_t)lane * RC + row] = lane == 0 ? sq : 0.f; }
            }
        } else if ((s == 1 || s == 7) && (PHM & 2)) {
            const int N = (s == 1) ? NE : NO;
            pg8::Gemm g{XB, (const bf16_t*)(ws + (s == 1 ? W_INE : W_INO)), RC, N, DM}; pg8::StaticOrder SO; SO.init(RC, N, G, bx);
            pg8::EpiScaleBf16 E{QKV, (s == 1) ? NEP : NOP, ssq + (s == 1 ? 0 : 2) * (size_t)RC, (s == 1) ? 3 : 0, (s == 1) ? 5 : 4, C2};
            for (int rep = 0; rep < ((DUP & 4) ? 2 : 1); ++rep) pg8::gemm_phase<pg8::EpiScaleBf16>(lds, g, SO, E, wave);
        } else if ((s == 4 || s == 6 || s == 9 || s == 11) && (PHM & 4)) {
            const bool dn = (s == 6 || s == 11); const int K = dn ? DFF : DM;
            const size_t woff = (s == 4) ? W_OUTE : (s == 6) ? W_DN0 : (s == 9) ? W_OUTO : W_DN1;
            pg8::Gemm g{dn ? HB : OB, (const bf16_t*)(ws + woff), RC, DM, K}; pg8::StaticOrder SO; SO.init(RC, DM, G, bx);
            const int qi = (s == 4) ? 1 : (s == 6) ? 2 : (s == 9) ? 3 : 4;
            pg8::EpiResidual E{XB, ssq + (size_t)qi * RC};
            pg8::gemm_phase<pg8::EpiResidual>(lds, g, SO, E, wave);
        } else if ((s == 5 || s == 10) && (PHM & 8)) {
            pg8::Gemm g{XB, (const bf16_t*)(ws + (s == 5 ? W_GU0 : W_GU1)), RC, NGU, DM}; pg8::StaticOrder SO; SO.init(RC, NGU, G, bx);
            pg8::EpiSwiGLU E{HB, ssq + (size_t)(s == 5 ? 1 : 3) * RC};
            for (int rep = 0; rep < ((DUP & 4) ? 2 : 1); ++rep) pg8::gemm_phase<pg8::EpiSwiGLU>(lds, g, SO, E, wave);
        } else if (s == 2 && (PHM & 16)) {
            const float* gq = KA(6); const float* gk = KA(7);
            for (int grp = gw; grp < RC / 4; grp += NGW) {
                const int row0 = 4 * grp, cc = lane & 7;
                bf16_t* qptr = QKV + (size_t)row0 * NEP + (lane >> 3) * 64 + cc * 8;
                const int rsub = lane >> 4;
                bf16_t* kptr = QKV + (size_t)(row0 + rsub) * NEP + 512 + ((lane >> 3) & 1) * 64 + cc * 8;
                u32x4 rq[4];
#pragma unroll
                for (int q = 0; q < 4; ++q) rq[q] = *(const u32x4*)(qptr + (size_t)q * NEP);
                const u32x4 rk = *(const u32x4*)kptr;
#pragma unroll
                for (int q = 0; q < 4; ++q) { const int t = (row0 + q) & (S - 1); *(u32x4*)(qptr + (size_t)q * NEP) = prep_item(rq[q], gq + cc * 8, rope, t >> 6, t & 63, cc, C2); }
                { const int t = (row0 + rsub) & (S - 1); *(u32x4*)kptr = prep_item(rk, gk + cc * 8, rope, t >> 6, t & 63, cc, 1.f); }
            }
            { LAS float* tabL = (LAS float*)(lds + RPB_OFF); const float* rpb = KA(8);
              for (int i = tid; i < 3720; i += NTHREADS) tabL[i] = rpb[i] * LOG2E;
              __syncthreads();
              const int rows = S >> 6; const int ntask = nb * rows * 16;
              LAS unsigned char* wl = lds + wave * 16384;
              for (int rep = 0; rep < ((DUP & 2) ? 2 : 1); ++rep)
              for (int wt = gw; wt < ntask; wt += NGW) {
                  const int qh = wt & 1, h = (wt >> 1) & 7, br = wt >> 4, r = br % rows, b = br / rows;
                  const int rs0 = min(max(r - 4, 0), rows - 8);
                  const size_t rowbase = (size_t)b * S;
                  const int qc = qh * 32 + r32, cs = min(max(qc - 8, 0), 48);
                  const bf16_t* qp = QKV + (rowbase + r * 64 + qc) * NEP + 768 + h * 64 + hi * 8;
                  bf16x8 qr[4];
#pragma unroll
                  for (int d0 = 0; d0 < 4; ++d0) qr[d0] = *(const bf16x8*)(qp + d0 * 16);
                  f32x16 o[2]; o[0] = (f32x16){}; o[1] = (f32x16){}; f32x16 negm = (f32x16){}; float mref = 0.f, l = 0.f;
                  const int lrow = lane >> 3, ch = lane & 7;
                  const int lrowV = 2 * (lane >> 4) + ((lane >> 2) & 1), dhV = (lane >> 3) & 1, cwV = lane & 3;
                  const int cbase = 24 * qh;
                  const bf16_t* kp = QKV + (rowbase + (size_t)rs0 * 64 + cbase + lrow) * NEP + 1280 + h * 64 + ch * 8;
                  const bf16_t* vp = QKV + (rowbase + (size_t)rs0 * 64 + cbase + lrowV) * NEP + 1792 + h * 64 + dhV * 32 + cwV * 8;
                  u32x4 kr[8], vr[8];
#define NAP_LOAD(T_) do { _Pragma("unroll") for (int j = 0; j < 8; ++j) { const int g_ = 8 * (T_) + j, kr_ = (g_ * 205) >> 10, kc_ = g_ - 5 * kr_; const size_t off_ = (size_t)(kr_ * 64 + kc_ * 8) * NEP; \
                      kr[j] = *(const u32x4*)(kp + off_); vr[j] = *(const u32x4*)(vp + off_); } } while (0)
                  NAP_LOAD(0);
                  const int kcs = 4 * hi - cs;
                  for (int jt = 0; jt < 5; ++jt) {
                      LAS unsigned char* kw = wl + ch * 1024 + (lrow ^ ch) * 16; LAS unsigned char* vw = wl + 8192 + dhV * 4096 + lrowV * 64 + cwV * 16; asm volatile("" : "+v"(kw), "+v"(vw));
#pragma unroll
                      for (int j = 0; j < 8; ++j) { *(LAS u32x4*)(kw + j * 128) = kr[j]; *(LAS u32x4*)(vw + j * 512) = vr[j]; }
                      int kcs_ = kcs; asm volatile("" : "+v"(kcs_));
                      ModNAP mod; mod.kcs = kcs_; mod.tl = tabL + (15 - qc + 4 * hi);
#pragma unroll
                      for (int g = 0; g < 8; ++g) { const int g_ = 8 * jt + g, kr_ = (g_ * 205) >> 10, kc_ = g_ - 5 * kr_; mod.C8[g] = cbase + kc_ * 8; mod.U[g] = (h * 15 + (rs0 + kr_ - r + 7)) * 31 + cbase + kc_ * 8; }
                      bf16x8 pa[4];
                      if (jt + 1 < 5) NAP_LOAD(jt + 1);
                      f32x16 s0, s1;
                      qkt2(s0, s1, wl, qr, negm, r32, hi);
                      softmax2<false>(s0, s1, o, negm, mref, l, wsf, lane, mod, pa, s0, s1);
                      pv_lane(o, wl + 8192, pa, lane);
                      asm volatile("" ::: "memory");
                  }
#undef NAP_LOAD
                  flash_finish(o, l, wsf, wl, OB + (rowbase + r * 64 + qh * 32) * DM + 512 + h * 64, DM, lane);
              } }
        } else if (s == 3 && (PHM & 32)) {
            const int nqb = S >> 8, ntask = nb * 8 * nqb, NT = S >> 6;
            LAS unsigned char* stg = lds + 81920 + wave * 4096;
            float gqm = 0.f, gkm = 0.f;
            { const float* gq = KA(6); const float* gk = KA(7);
              for (int i = 0; i < 64; ++i) { gqm = fmaxf(gqm, __builtin_fabsf(gq[i])); gkm = fmaxf(gkm, __builtin_fabsf(gk[i])); } }
            const float sbound = 64.f * C2 * gqm * gkm * 1.001f;
            const bool fastA = sbound < 64.f;
            for (int rep = 0; rep < ((DUP & 1) ? 2 : 1); ++rep)
            for (int task = vcu; task < ntask; task += G) {
                const int qb = task % nqb, bh = task / nqb, h = bh & 7, b = bh >> 3;
                const size_t rowbase = (size_t)b * S;
                const int q0 = qb * 256 + wave * 32;
                const bf16_t* qp = QKV + (rowbase + q0 + r32) * NEP + h * 64 + hi * 8;
                bf16x8 qr[4];
#pragma unroll
                for (int d0 = 0; d0 < 4; ++d0) qr[d0] = *(const bf16x8*)(qp + d0 * 16);
                f32x16 o[2]; o[0] = (f32x16){}; o[1] = (f32x16){}; float l = 0.f;
                const int trow = wave * 8 + (lane >> 3), ch = lane & 7;
                const int trowV = wave * 8 + 2 * (lane >> 4) + ((lane >> 2) & 1), dhV = (lane >> 3) & 1, cwV = lane & 3;
                const bf16_t* kp = QKV + (rowbase + trow) * NEP + 512 + (h >> 2) * 64 + ch * 8;
                const bf16_t* vp = QKV + (rowbase + trowV) * NEP + 640 + (h >> 2) * 64 + dhV * 32 + cwV * 8;
                const unsigned kdst = ch * 1024 + (trow ^ ch) * 16, vdst = 8192 + dhV * 4096 + trowV * 64 + cwV * 16;
                u32x4 kreg = *(const u32x4*)kp, vreg = *(const u32x4*)vp;
                if (!fastA) {
                    float m = -1e30f;
                    *(LAS u32x4*)(lds + kdst) = kreg; *(LAS u32x4*)(lds + vdst) = vreg;
                    __syncthreads();
                    for (int t = 0; t < NT; ++t) {
                        const unsigned cur = (t & 1) * 16384u, nxt = 16384u - cur;
                        if (t + 1 < NT) { kreg = *(const u32x4*)(kp + (size_t)(t + 1) * 64 * NEP); vreg = *(const u32x4*)(vp + (size_t)(t + 1) * 64 * NEP); }
                        flash_step(lds + cur, lds + cur + 8192, qr, o, m, l, wsf, lane, ModNone{});
                        if (t + 1 < NT) { *(LAS u32x4*)(lds + nxt + kdst) = kreg; *(LAS u32x4*)(lds + nxt + vdst) = vreg; }
                        __syncthreads();
                    }
                    flash_finish(o, l, wsf, stg, OB + (rowbase + q0) * DM + h * 64, DM, lane);
                    continue;
                }
                u32x4 kreg1 = *(const u32x4*)(kp + (size_t)64 * NEP), vreg1 = *(const u32x4*)(vp + (size_t)64 * NEP);
                u32x4 kreg2 = *(const u32x4*)(kp + (size_t)128 * NEP), vreg2 = *(const u32x4*)(vp + (size_t)128 * NEP);
                *(LAS u32x4*)(lds + kdst) = kreg; *(LAS u32x4*)(lds + vdst) = vreg;
                *(LAS u32x4*)(lds + 16384 + kdst) = kreg1; *(LAS u32x4*)(lds + 16384 + vdst) = vreg1;
                *(LAS u32x4*)(lds + 32768 + kdst) = kreg2; *(LAS u32x4*)(lds + 32768 + vdst) = vreg2;
                __syncthreads();
                f32x16 sa0, sa1, sb0, sb1;
                { const f32x16 z_ = (f32x16){}; qkt2(sa0, sa1, lds, qr, z_, r32, hi); }
                unsigned bcur = 0, bnxt = 16384, bnn = 49152;
                const int vbl = ((lane >> 4) & 1) * 32 + (lane & 3) * 8 + (4 * hi + ((lane & 15) >> 2)) * 64;
#define A_SCHED __builtin_amdgcn_sched_barrier(0)
#define A_STEP(C0, C1, N0, N1, T_) do { \
                    if ((T_) + 3 < NT) { kreg = *(const u32x4*)(kp + (size_t)((T_) + 3) * 64 * NEP); vreg = *(const u32x4*)(vp + (size_t)((T_) + 3) * 64 * NEP); } \
                    bf16x8 kf[4], kg[4]; \
                    { _Pragma("unroll") for (int d0 = 0; d0 < 2; ++d0) { LAS const unsigned char* kb_ = lds + bnxt + (2 * d0 + hi) * 1024 + ((r32 ^ (2 * d0 + hi)) * 16); asm volatile("" : "+v"(kb_)); \
                        kf[2 * d0] = *(LAS const bf16x8*)(kb_); kf[2 * d0 + 1] = *(LAS const bf16x8*)(kb_ + 512); } } \
                    A_SCHED; \
                    { _Pragma("unroll") for (int d0 = 2; d0 < 4; ++d0) { LAS const unsigned char* kb_ = lds + bnxt + (2 * d0 + hi) * 1024 + ((r32 ^ (2 * d0 + hi)) * 16); asm volatile("" : "+v"(kb_)); \
                        kg[2 * d0 - 4] = *(LAS const bf16x8*)(kb_); kg[2 * d0 - 3] = *(LAS const bf16x8*)(kb_ + 512); } } \
                    N0 = __builtin_amdgcn_mfma_f32_32x32x16_bf16(kf[0], qr[0], (f32x16){}, 0, 0, 0); N1 = __builtin_amdgcn_mfma_f32_32x32x16_bf16(kf[1], qr[0], (f32x16){}, 0, 0, 0); \
                    N0 = __builtin_amdgcn_mfma_f32_32x32x16_bf16(kf[2], qr[1], N0, 0, 0, 0);   N1 = __builtin_amdgcn_mfma_f32_32x32x16_bf16(kf[3], qr[1], N1, 0, 0, 0); \
                    A_SCHED; \
                    N0 = __builtin_amdgcn_mfma_f32_32x32x16_bf16(kg[0], qr[2], N0, 0, 0, 0);   N1 = __builtin_amdgcn_mfma_f32_32x32x16_bf16(kg[1], qr[2], N1, 0, 0, 0); \
                    N0 = __builtin_amdgcn_mfma_f32_32x32x16_bf16(kg[2], qr[3], N0, 0, 0, 0);   N1 = __builtin_amdgcn_mfma_f32_32x32x16_bf16(kg[3], qr[3], N1, 0, 0, 0); \
                    A_SCHED; \
                    s16x4 vlo[4], vhi[4]; \
                    { LAS const unsigned char* vp_ = lds + bcur + 8192 + vbl; asm volatile("" : "+v"(vp_)); \
                      _Pragma("unroll") for (int i = 0; i < 4; ++i) { vlo[i] = vtr(vp_ + (i & 3) * 1024); vhi[i] = vtr(vp_ + (i & 3) * 1024 + 512); } } \
                    A_SCHED; \
                    float s_ = 0.f; \
                    _Pragma("unroll") for (int r = 0; r < 16; ++r) { C0[r] = __builtin_amdgcn_exp2f(C0[r]); C1[r] = __builtin_amdgcn_exp2f(C1[r]); s_ += C0[r] + C1[r]; } \
                    l += s_; \
                    bf16x8 pa[4]; \
                    { u32x4 w; \
                      w = (u32x4){cvtpk(C0[0], C0[1]), cvtpk(C0[2], C0[3]), cvtpk(C0[4], C0[5]), cvtpk(C0[6], C0[7])}; pa[0] = __builtin_bit_cast(bf16x8, w); \
                      w = (u32x4){cvtpk(C0[8], C0[9]), cvtpk(C0[10], C0[11]), cvtpk(C0[12], C0[13]), cvtpk(C0[14], C0[15])}; pa[1] = __builtin_bit_cast(bf16x8, w); \
                      w = (u32x4){cvtpk(C1[0], C1[1]), cvtpk(C1[2], C1[3]), cvtpk(C1[4], C1[5]), cvtpk(C1[6], C1[7])}; pa[2] = __builtin_bit_cast(bf16x8, w); \
                      w = (u32x4){cvtpk(C1[8], C1[9]), cvtpk(C1[10], C1[11]), cvtpk(C1[12], C1[13]), cvtpk(C1[14], C1[15])}; pa[3] = __builtin_bit_cast(bf16x8, w); } \
                    A_SCHED; \
                    _Pragma("unroll") for (int i = 0; i < 4; ++i) { const bf16x8 vf = (bf16x8){vlo[i][0], vlo[i][1], vlo[i][2], vlo[i][3], vhi[i][0], vhi[i][1], vhi[i][2], vhi[i][3]}; \
                        o[0] = __builtin_amdgcn_mfma_f32_32x32x16_bf16(pa[i], vf, o[0], 0, 0, 0); } \
                    A_SCHED; \
                    { LAS const unsigned char* vp_ = lds + bcur + 8192 + 4096 + vbl; asm volatile("" : "+v"(vp_)); \
                      _Pragma("unroll") for (int i = 0; i < 4; ++i) { vlo[i] = vtr(vp_ + i * 1024); vhi[i] = vtr(vp_ + i * 1024 + 512); } } \
                    if ((T_) + 3 < NT) { *(LAS u32x4*)(lds + bnn + kdst) = kreg; *(LAS u32x4*)(lds + bnn + vdst) = vreg; } \
                    A_SCHED; \
                    _Pragma("unroll") for (int i = 0; i < 4; ++i) { const bf16x8 vf = (bf16x8){vlo[i][0], vlo[i][1], vlo[i][2], vlo[i][3], vhi[i][0], vhi[i][1], vhi[i][2], vhi[i][3]}; \
                        o[1] = __builtin_amdgcn_mfma_f32_32x32x16_bf16(pa[i], vf, o[1], 0, 0, 0); } \
                    if (BAR_) __syncthreads(); \
                    bcur = bnxt; bnxt = (bnxt == 65536u) ? 0u : bnxt + 16384u; bnn = (bnn == 65536u) ? 0u : bnn + 16384u; \
                } while (0)
                for (int t = 0; t < NT; t += 2) {
#define BAR_ false
                    A_STEP(sa0, sa1, sb0, sb1, t);
#undef BAR_
#define BAR_ true
                    A_STEP(sb0, sb1, sa0, sa1, t + 1);
#undef BAR_
                }
#undef A_STEP
#undef A_SCHED
                flash_finish(o, l, wsf, stg, OB + (rowbase + q0) * DM + h * 64, DM, lane);
            }
        } else if (s == 8 && (PHM & 64)) {
            const int nib = S >> 9, nqb = S >> 5;
            LAS unsigned char* wl = lds + wave * 16384;
            float* LSE = (float*)(ws + WS_LSE);
            for (int pass = 0; pass < 2; ++pass) {
            const int ntask = pass == 0 ? nb * 16 * nqb : nb * 16 * nib * 16;
            const int qstep = pass == 0 ? 1 : 16, ubeg = pass == 0 ? 0 : 10, uend = pass == 0 ? 3 : 17;
            for (int wt = gw; wt < ntask; wt += NGW) {
                int tmin, h, b;
                if (pass == 0) { const int qb = wt % nqb, bh = wt / nqb; h = bh & 15; b = bh >> 4; tmin = qb * 32; }
                else { const int rho = wt & 15, ib = (wt >> 4) % nib, bh = (wt >> 4) / nib; h = bh & 15; b = bh >> 4; tmin = rho + 512 * ib; }
                const size_t rowbase = (size_t)b * S;
                const int tq = tmin + qstep * r32;
                const float slope2 = __builtin_amdgcn_exp2f(-0.5f * (float)(h + 1)) * LOG2E;
                const bf16_t* qp = QKV + (rowbase + tq) * NOP + h * 64 + hi * 8;
                bf16x8 qr[4];
#pragma unroll
                for (int d0 = 0; d0 < 4; ++d0) qr[d0] = *(const bf16x8*)(qp + d0 * 16);
                f32x16 o[2]; o[0] = (f32x16){}; o[1] = (f32x16){}; f32x16 negm = (f32x16){}; float mref = 0.f, l = 0.f;
                const int lrow = lane >> 3, ch = lane & 7;
                const int lrowV = 2 * (lane >> 4) + ((lane >> 2) & 1), dhV = (lane >> 3) & 1, cwV = lane & 3;
                const bf16_t* kb = QKV + rowbase * NOP + 1024 + h * 64 + ch * 8;
                const bf16_t* vb = QKV + rowbase * NOP + 2048 + h * 64 + dhV * 32 + cwV * 8;
                u32x4 kr[8], vr[8];
#define DIL_TILE(u, SH, T0) do { const int g_ = (u) < 10 ? 0 : ((u) < 14 ? 1 : 2); SH = 2 * g_; const int tt_ = (u) - (g_ == 0 ? 0 : (g_ == 1 ? 10 : 14)); T0 = tmin - (64 << SH) + ((64 * tt_) << SH); } while (0)
#define DIL_LOADK(SH, T0) do { int lr_ = lrow; asm volatile("" : "+v"(lr_)); _Pragma("unroll") for (int j = 0; j < 8; ++j) { const int tk_ = min(max(T0 + ((lr_ + 8 * j) << SH), 0), S - 1); kr[j] = *(const u32x4*)(kb + (size_t)tk_ * NOP); } } while (0)
#define DIL_LOADV(SH, T0) do { int lr_ = lrowV; asm volatile("" : "+v"(lr_)); _Pragma("unroll") for (int j = 0; j < 8; ++j) { const int tv_ = min(max(T0 + ((lr_ + 8 * j) << SH), 0), S - 1); vr[j] = *(const u32x4*)(vb + (size_t)tv_ * NOP); } } while (0)
                int sh, t0; DIL_TILE(ubeg, sh, t0); DIL_LOADK(sh, t0); DIL_LOADV(sh, t0);
                for (int u = ubeg; u < uend; ++u) {
                    LAS unsigned char* kw = wl + ch * 1024 + (lrow ^ ch) * 16; LAS unsigned char* vw = wl + 8192 + dhV * 4096 + lrowV * 64 + cwV * 16; asm volatile("" : "+v"(kw), "+v"(vw));
#pragma unroll
                    for (int j = 0; j < 8; ++j) { *(LAS u32x4*)(kw + j * 128) = kr[j]; *(LAS u32x4*)(vw + j * 512) = vr[j]; }
                    int tq_ = tq; asm volatile("" : "+v"(tq_));
                    ModDil mod{(float)(tq_ - t0 - ((4 * hi) << sh)), (float)(1 << sh), (float)(64 << sh), slope2, (float)tq_, (float)(tq_ - S), (t0 >= 0) && (t0 + (63 << sh) < S)};
                    bf16x8 pa[4];
                    if (u + 1 < uend) { DIL_TILE(u + 1, sh, t0); DIL_LOADK(sh, t0); }
                    f32x16 s0, s1;
                    qkt2(s0, s1, wl, qr, negm, r32, hi);
                    softmax2<false>(s0, s1, o, negm, mref, l, wsf, lane, mod, pa, s0, s1);
                    asm volatile("" ::: "memory");
                    if (u + 1 < uend) { DIL_LOADV(sh, t0); }
                    pv_lane(o, wl + 8192, pa, lane);
                    asm volatile("" ::: "memory");
                }
#undef DIL_TILE
#undef DIL_LOADK
#undef DIL_LOADV
                flash_finish_c(o, l, mref, wsf, wl, OB + (rowbase + tmin) * DM + h * 64, (size_t)qstep * DM, lane, LSE + (rowbase + tmin) * 16 + h, qstep * 16, pass == 1);
            }
            if (pass == 0) xcd_barrier(xbar);
            }
        }
        if (ph == 0) grid.sync(); else if (ph < 24) xcd_barrier(xbar);
    }
}

#undef KA
extern "C" void kernel_launch(void* const* d_in, const int* in_sizes, int n_in, void* d_out, int out_size, void* d_ws, size_t ws_size, hipStream_t stream) {
    static int grid_blocks = 0;
    if (!grid_blocks) {
        int dev = 0, cus = 0, per_cu = 0;
        hipGetDevice(&dev);
        hipDeviceGetAttribute(&cus, hipDeviceAttributeMultiprocessorCount, dev);
        hipFuncSetAttribute((const void*)fwd_megakernel, hipFuncAttributeMaxDynamicSharedMemorySize, LDS_BYTES);
        hipOccupancyMaxActiveBlocksPerMultiprocessor(&per_cu, (const void*)fwd_megakernel, NTHREADS, LDS_BYTES);
        if (per_cu < 1) per_cu = 1;
        grid_blocks = cus * per_cu;
        if (n_in != 14 || ws_size < WS_END) fprintf(stderr, "kernel_launch: unexpected n_in %d / ws_size %zu\n", n_in, ws_size);
    }
    (void)hipMemsetAsync((char*)d_ws + WS_BAR, 0, 16384, stream);
    Params p{};
    for (int i = 0; i < 14; ++i) p.in[i] = (const float*)d_in[i];
    p.out = (float*)d_out; p.ws = (unsigned char*)d_ws;
    void* args[] = {&p};
    hipError_t e = hipLaunchCooperativeKernel((const void*)fwd_megakernel, dim3(grid_blocks), dim3(NTHREADS), args, LDS_BYTES, stream);
    if (e != hipSuccess) fprintf(stderr, "cooperative launch failed: %s (grid %d)\n", hipGetErrorString(e), grid_blocks);
}
```

```cpp
#include <hip/hip_runtime.h>
#include <hip/hip_cooperative_groups.h>
#include <cstdio>
#include <cstdint>
namespace cg = cooperative_groups;

#define LAS __attribute__((address_space(3)))
typedef unsigned short bf16_t;
typedef short bf16x8 __attribute__((ext_vector_type(8)));
typedef short s16x4 __attribute__((ext_vector_type(4)));
typedef float f32x2 __attribute__((ext_vector_type(2)));
typedef float f32x4 __attribute__((ext_vector_type(4)));
typedef float f32x16 __attribute__((ext_vector_type(16)));
typedef unsigned u32x2 __attribute__((ext_vector_type(2)));
typedef unsigned u32x4 __attribute__((ext_vector_type(4)));
typedef __bf16 bf16x2_t __attribute__((ext_vector_type(2)));

constexpr int DM = 1024, DFF = 2816, RC = 65536;
constexpr int NE = 2304, NO = 3072, NGU = 5632;
constexpr int NEP = NE + 64, NOP = NO + 64;
constexpr float EPS = 1e-6f, LOG2E = 1.4426950408889634f, C2 = 0.125f * 1.4426950408889634f;
constexpr int NTHREADS = 512, NWAVES = 8;
#ifndef PHM
#define PHM 127
#endif
#ifndef DUP
#define DUP 0
#endif

constexpr size_t MiB = 1u << 20;
constexpr size_t WS_ROPE = 0;
constexpr size_t WS_BAR = 65536;
constexpr size_t WS_SSQ = 1 * MiB;
constexpr size_t WS_W = 4 * MiB;
constexpr size_t W_INE = WS_W, W_OUTE = W_INE + (size_t)NE * DM * 2, W_INO = W_OUTE + (size_t)DM * DM * 2, W_OUTO = W_INO + (size_t)NO * DM * 2;
constexpr size_t W_GU0 = W_OUTO + (size_t)DM * DM * 2, W_GU1 = W_GU0 + (size_t)NGU * DM * 2, W_DN0 = W_GU1 + (size_t)NGU * DM * 2, W_DN1 = W_DN0 + (size_t)DM * DFF * 2;
constexpr size_t W_END = W_DN1 + (size_t)DM * DFF * 2;
constexpr size_t WS_XB = 52 * MiB;
constexpr size_t WS_QKV = 180 * MiB;
constexpr size_t WS_H = 180 * MiB;
constexpr size_t WS_O = 576 * MiB;
constexpr size_t WS_XB1 = 704 * MiB;
constexpr size_t WS_LSE = 832 * MiB;
constexpr size_t WS_END = 836 * MiB;
static_assert(W_END <= WS_XB, "weights fit");
static_assert(WS_QKV + (size_t)RC * NOP * 2 <= WS_O && WS_H + (size_t)RC * DFF * 2 <= WS_O, "qkv/h fit");

constexpr int RING_BYTES = 131072;
constexpr int WSF_OFF = RING_BYTES;
constexpr int RPB_OFF = WSF_OFF + 2048;
constexpr int PTAB_OFF = 148736;
constexpr int LDS_BYTES = 151552;
static_assert(RPB_OFF + 3720 * 4 + 512 <= PTAB_OFF && PTAB_OFF + 128 <= LDS_BYTES, "lds map");
__device__ __forceinline__ const float* ldptr(LAS const unsigned long long* tab, int i) {
    const unsigned long long v = tab[i];
    const unsigned lo = __builtin_amdgcn_readfirstlane((unsigned)v), hi = __builtin_amdgcn_readfirstlane((unsigned)(v >> 32));
    return (const float*)(((unsigned long long)hi << 32) | lo);
}

__device__ __forceinline__ unsigned cvtpk(float lo, float hi) { f32x2 v = {lo, hi}; bf16x2_t b = __builtin_convertvector(v, bf16x2_t); return __builtin_bit_cast(unsigned, b); }
__device__ __forceinline__ float bf2f(unsigned short h) { return __builtin_bit_cast(float, (unsigned)h << 16); }
__device__ __forceinline__ float wave_sum(float v) {
#pragma unroll
    for (int o = 1; o < 64; o <<= 1) v += __shfl_xor(v, o);
    return v;
}

namespace pg8 {
constexpr int BM = 256, BK = 64, HALF = 128, HTB = HALF * BK * 2, STAGE_BYTES = 8 * HTB, NXCD = 8, WGM = 8;
__host__ __device__ __forceinline__ int lds_byte(int r, int c) { const int st = (r >> 4) * 2 + (c >> 5), rr = r & 15, cc = c & 31, ob = rr * 64 + cc * 2; return st * 1024 + (ob ^ (((ob >> 9) & 1) << 5)); }
__host__ __device__ __forceinline__ void stage_rc(int b, int& R, int& C) { const int st = b / 1024, sb = b % 1024, swz = sb ^ (((sb >> 9) & 1) << 5); R = (st >> 1) * 16 + swz / 64; C = (st & 1) * 32 + (swz % 64) / 2; }
__host__ __device__ __forceinline__ int perm32(int rho) { const int n = rho >> 4, i = rho & 15; return 8 * (i >> 2) + 4 * n + (i & 3); }
struct Unit { int pm, pn; };
struct Gemm { const bf16_t* A; const bf16_t* Bt; int M, N, K; };
struct StaticOrder {
    int nM, nN, nwg, G, c;
    __host__ __device__ void init(int M, int N, int G_, int c_) { nM = M / BM; nN = N / BM; nwg = nM * nN; G = G_; c = c_; }
    __host__ __device__ bool next(int i, Unit& u) const {
        const long L = (long)i * G + c; if (L >= nwg) return false;
        int wgid = (int)L; { const int q = nwg / NXCD, r = nwg % NXCD, xcd = wgid % NXCD, off = wgid / NXCD; wgid = (xcd < r ? xcd * (q + 1) : r * (q + 1) + (xcd - r) * q) + off; }
        const int nig = WGM * nN, gid = wgid / nig, fm = gid * WGM, gsz = (nM - fm) < WGM ? (nM - fm) : WGM;
        u.pm = fm + ((wgid % nig) % gsz); u.pn = (wgid % nig) / gsz; return true;
    }
};

struct EpiScaleBf16 {
    static constexpr bool PERM = true;
    bf16_t* O; int ldc; const float* ssq; int t0, t1; float tscale;
    __device__ __forceinline__ void pre(const Unit& u, int wr, int fr, float (&pv)[8]) const {
        const int row0 = u.pm * BM + wr * 64 + fr;
#pragma unroll
        for (int i = 0; i < 8; ++i) pv[i] = ssq[row0 + (i >> 2) * HALF + (i & 3) * 16];
    }
    __device__ __forceinline__ void operator()(const f32x4 (&acc)[2][2][4][2], const Unit& u, int wr, int wc, int fr, int fq, const float (&pv)[8]) const {
        const int row0 = u.pm * BM + wr * 64 + fr, col0 = u.pn * BM + wc * 32 + 8 * fq;
        const float sc = (u.pn >= t0 && u.pn < t1) ? tscale : 1.f;
#pragma unroll
        for (int ai = 0; ai < 2; ++ai)
#pragma unroll
            for (int m = 0; m < 4; ++m) { const int row = row0 + ai * HALF + m * 16; const float rs = __builtin_amdgcn_rsqf(pv[ai * 4 + m] * (1.f / DM) + EPS) * sc;
                bf16_t* rowp = O + (size_t)row * ldc + col0;
#pragma unroll
                for (int bj = 0; bj < 2; ++bj) { const f32x4 v0 = acc[ai][bj][m][0] * rs, v1 = acc[ai][bj][m][1] * rs;
                    u32x4 w; w.x = cvtpk(v0[0], v0[1]); w.y = cvtpk(v0[2], v0[3]); w.z = cvtpk(v1[0], v1[1]); w.w = cvtpk(v1[2], v1[3]);
                    *(u32x4*)(rowp + bj * HALF) = w; } }
    }
};
struct EpiSwiGLU {
    static constexpr bool PERM = true;
    bf16_t* H; const float* ssq;
    __device__ __forceinline__ void pre(const Unit& u, int wr, int fr, float (&pv)[8]) const {
        const int row0 = u.pm * BM + wr * 64 + fr;
#pragma unroll
        for (int i = 0; i < 8; ++i) pv[i] = ssq[row0 + (i >> 2) * HALF + (i & 3) * 16];
    }
    __device__ __forceinline__ void operator()(const f32x4 (&acc)[2][2][4][2], const Unit& u, int wr, int wc, int fr, int fq, const float (&pv)[8]) const {
        const int row0 = u.pm * BM + wr * 64 + fr, col0 = u.pn * HALF + wc * 32 + 8 * fq;
#pragma unroll
        for (int ai = 0; ai < 2; ++ai)
#pragma unroll
            for (int m = 0; m < 4; ++m) { const int row = row0 + ai * HALF + m * 16; const float rs = __builtin_amdgcn_rsqf(pv[ai * 4 + m] * (1.f / DM) + EPS);
                float hv[8];
#pragma unroll
                for (int n = 0; n < 2; ++n)
#pragma unroll
                    for (int j = 0; j < 4; ++j) { const float g = acc[ai][0][m][n][j] * rs, uu = acc[ai][1][m][n][j] * rs;
                        const float e = __builtin_amdgcn_exp2f(-g * LOG2E); hv[n * 4 + j] = g * uu * __builtin_amdgcn_rcpf(1.f + e); }
                u32x4 w; w.x = cvtpk(hv[0], hv[1]); w.y = cvtpk(hv[2], hv[3]); w.z = cvtpk(hv[4], hv[5]); w.w = cvtpk(hv[6], hv[7]);
                *(u32x4*)(H + (size_t)row * DFF + col0) = w; }
    }
};
struct EpiResidual {
    static constexpr bool PERM = true;
    bf16_t* xb; float* ssq;
    __device__ __forceinline__ void pre(const Unit&, int, int, float (&)[8]) const {}
    __device__ __forceinline__ void operator()(const f32x4 (&acc)[2][2][4][2], const Unit& u, int wr, int wc, int fr, int fq, const float (&)[8]) const {
        const int row0 = u.pm * BM + wr * 64 + fr, col0 = u.pn * BM + wc * 32 + 8 * fq;
#pragma unroll
        for (int ai = 0; ai < 2; ++ai)
#pragma unroll
            for (int m = 0; m < 4; ++m) { const int row = row0 + ai * HALF + m * 16; bf16_t* rowp = xb + (size_t)row * DM + col0; float s = 0.f;
                u32x4 raw[2];
#pragma unroll
                for (int bj = 0; bj < 2; ++bj) raw[bj] = *(const u32x4*)(rowp + bj * HALF);
#pragma unroll
                for (int bj = 0; bj < 2; ++bj) { const f32x4 a0 = acc[ai][bj][m][0], a1 = acc[ai][bj][m][1]; const u32x4 r = raw[bj];
                    const float x0 = __builtin_bit_cast(float, r.x << 16) + a0[0], x1 = __builtin_bit_cast(float, r.x & 0xffff0000u) + a0[1];
                    const float x2 = __builtin_bit_cast(float, r.y << 16) + a0[2], x3 = __builtin_bit_cast(float, r.y & 0xffff0000u) + a0[3];
                    const float x4 = __builtin_bit_cast(float, r.z << 16) + a1[0], x5 = __builtin_bit_cast(float, r.z & 0xffff0000u) + a1[1];
                    const float x6 = __builtin_bit_cast(float, r.w << 16) + a1[2], x7 = __builtin_bit_cast(float, r.w & 0xffff0000u) + a1[3];
                    u32x4 w; w.x = cvtpk(x0, x1); w.y = cvtpk(x2, x3); w.z = cvtpk(x4, x5); w.w = cvtpk(x6, x7);
                    *(u32x4*)(rowp + bj * HALF) = w;
                    s += ((x0 * x0 + x1 * x1) + (x2 * x2 + x3 * x3)) + ((x4 * x4 + x5 * x5) + (x6 * x6 + x7 * x7)); }
                s += __shfl_xor(s, 16); s += __shfl_xor(s, 32);
                if (fq == 0) atomicAdd(ssq + row, s); }
    }
};

template <class Epi>
__device__ __forceinline__ void gemm_phase(LAS unsigned char* lds, const Gemm g, const StaticOrder& S, const Epi& E, const int wave_id) {
    int tid = threadIdx.x; asm volatile("" : "+v"(tid));
    const int wid = __builtin_amdgcn_readfirstlane(tid >> 6), lane = tid & 63, wr = wid >> 2, wc = wid & 3, fr = lane & 15, fq = lane >> 4;
    const int K = g.K, nt = K / BK;
    unsigned voffA[2], voffB[2];
#pragma unroll
    for (int i = 0; i < 2; ++i) { int R, C; stage_rc(tid * 16 + i * 8192, R, C); const int Rb = Epi::PERM ? ((R & ~31) + perm32(R & 31)) : R;
        voffA[i] = (unsigned)(R * K + C) * 2u; voffB[i] = (unsigned)(Rb * K + C) * 2u; }
    const size_t kstep = (size_t)(BK * 2);
    const size_t hstep = (size_t)HALF * K * 2;
    const size_t tstep = 2 * hstep;
    const unsigned ldsw = (unsigned)wid * 1024u;
    const int aoff = lds_byte(wr * 64 + fr, fq * 8), boff = lds_byte(wc * 32 + fr, fq * 8);
#define PG8_SA(b, h) (((b) * 2 + (h)) * HTB)
#define PG8_SB(b, h) ((4 + (b) * 2 + (h)) * HTB)
#define PG8_STAGE(bufoff, gbase, voff) do { _Pragma("unroll") for (int _i = 0; _i < 2; ++_i) \
        __builtin_amdgcn_global_load_lds((const unsigned*)((const char*)(gbase) + (voff)[_i]), (LAS unsigned*)(lds + (bufoff) + ldsw + _i * 8192), 16, 0, 0); } while (0)
#define PG8_LDA(dst, b, h) do { _Pragma("unroll") for (int m = 0; m < 4; ++m) _Pragma("unroll") for (int k = 0; k < 2; ++k) dst[m][k] = *(const LAS bf16x8*)(lds + PG8_SA(b, h) + aoff + m * 2048 + k * 1024); } while (0)
#define PG8_LDB(dst, b, h) do { _Pragma("unroll") for (int n = 0; n < 2; ++n) _Pragma("unroll") for (int k = 0; k < 2; ++k) dst[n][k] = *(const LAS bf16x8*)(lds + PG8_SB(b, h) + boff + n * 2048 + k * 1024); } while (0)
#define PG8_MMA(ai, bj, At, Bt) do { __builtin_amdgcn_s_setprio(1); _Pragma("unroll") for (int m = 0; m < 4; ++m) _Pragma("unroll") for (int n = 0; n < 2; ++n) _Pragma("unroll") for (int k = 0; k < 2; ++k) \
        acc[ai][bj][m][n] = __builtin_amdgcn_mfma_f32_16x16x32_bf16(Bt[n][k], At[m][k], acc[ai][bj][m][n], 0, 0, 0); __builtin_amdgcn_s_setprio(0); } while (0)
#define PG8_WAIT_V(n) asm volatile("s_waitcnt vmcnt(" #n ")" ::: "memory")
#define PG8_WAIT_L(n) asm volatile("s_waitcnt lgkmcnt(" #n ")" ::: "memory")
#define PG8_BAR __builtin_amdgcn_s_barrier()
#define PG8_SCHED __builtin_amdgcn_sched_barrier(0)
    Unit cur, nxt; int ui = 0;
    if (!S.next(0, cur)) return;
    f32x4 acc[2][2][4][2];
#pragma unroll
    for (int a = 0; a < 2; ++a)
#pragma unroll
        for (int b = 0; b < 2; ++b)
#pragma unroll
            for (int m = 0; m < 4; ++m)
#pragma unroll
                for (int n = 0; n < 2; ++n) acc[a][b][m][n] = (f32x4){0.f, 0.f, 0.f, 0.f};
    bf16x8 At[4][2], B0[2][2], B1[2][2];
    float epre[8] = {0.f, 0.f, 0.f, 0.f, 0.f, 0.f, 0.f, 0.f};
    const char* cA = (const char*)g.A + (size_t)cur.pm * tstep; const char* cB = (const char*)g.Bt + (size_t)cur.pn * tstep;
    PG8_STAGE(PG8_SB(0, 0), cB, voffB); PG8_STAGE(PG8_SB(0, 1), cB + hstep, voffB); PG8_STAGE(PG8_SA(0, 0), cA, voffA); PG8_STAGE(PG8_SA(0, 1), cA + hstep, voffA);
    if (wr == 1) PG8_BAR;
    PG8_WAIT_V(2); PG8_BAR;
    PG8_STAGE(PG8_SB(1, 0), cB + kstep, voffB); PG8_STAGE(PG8_SA(1, 0), cA + kstep, voffA); PG8_STAGE(PG8_SB(1, 1), cB + hstep + kstep, voffB);
    PG8_WAIT_V(6); PG8_BAR;
    for (;;) {
        const bool has_next = S.next(ui + 1, nxt);
        const char* nA = has_next ? (const char*)g.A + (size_t)nxt.pm * tstep : cA; const char* nB = has_next ? (const char*)g.Bt + (size_t)nxt.pn * tstep : cB;
        for (int t = 0; t < nt; t += 2) {
            const bool last = (t == nt - 2);
            if (last) E.pre(cur, wr, fr, epre);
            const char* a1 = cA + (size_t)(t + 1) * kstep;
            const char* a2 = last ? nA : cA + (size_t)(t + 2) * kstep; const char* b2 = last ? nB : cB + (size_t)(t + 2) * kstep;
            const char* a3 = a2 + kstep; const char* b3 = b2 + kstep;
            PG8_LDB(B0, 0, 0); PG8_LDB(B1, 0, 1); PG8_SCHED; PG8_LDA(At, 0, 0); PG8_STAGE(PG8_SA(1, 1), a1 + hstep, voffA);
            PG8_WAIT_V(8); PG8_WAIT_L(0); PG8_BAR; PG8_MMA(0, 0, At, B0); PG8_MMA(0, 1, At, B1); PG8_BAR; PG8_SCHED;
            PG8_LDA(At, 0, 1); PG8_STAGE(PG8_SB(0, 0), b2, voffB); PG8_STAGE(PG8_SB(0, 1), b2 + hstep, voffB); PG8_STAGE(PG8_SA(0, 0), a2, voffA);
            PG8_WAIT_V(8); PG8_WAIT_L(0); PG8_BAR; PG8_MMA(1, 0, At, B0); PG8_MMA(1, 1, At, B1); PG8_BAR; PG8_SCHED;
            PG8_LDB(B0, 1, 0); PG8_LDB(B1, 1, 1); PG8_SCHED; PG8_LDA(At, 1, 0); PG8_STAGE(PG8_SA(0, 1), a2 + hstep, voffA);
            PG8_WAIT_V(8); PG8_WAIT_L(0); PG8_BAR; PG8_MMA(0, 0, At, B0); PG8_MMA(0, 1, At, B1); PG8_BAR; PG8_SCHED;
            PG8_LDA(At, 1, 1); PG8_STAGE(PG8_SB(1, 0), b3, voffB); PG8_STAGE(PG8_SB(1, 1), b3 + hstep, voffB); PG8_STAGE(PG8_SA(1, 0), a3, voffA);
            PG8_WAIT_V(8); PG8_WAIT_L(0); PG8_BAR; PG8_MMA(1, 0, At, B0); PG8_MMA(1, 1, At, B1); PG8_BAR; PG8_SCHED;
        }
        if (wr == 0) PG8_BAR;
        E(acc, cur, wr, wc, fr, fq, epre);
        if (!has_next) break;
#pragma unroll
        for (int a = 0; a < 2; ++a)
#pragma unroll
            for (int b = 0; b < 2; ++b)
#pragma unroll
                for (int m = 0; m < 4; ++m)
#pragma unroll
                    for (int n = 0; n < 2; ++n) acc[a][b][m][n] = (f32x4){0.f, 0.f, 0.f, 0.f};
        cur = nxt; cA = nA; cB = nB; ++ui;
        if (wr == 1) PG8_BAR;
    }
    PG8_WAIT_V(0);
    PG8_BAR;
#undef PG8_SA
#undef PG8_SB
#undef PG8_STAGE
#undef PG8_LDA
#undef PG8_LDB
#undef PG8_MMA
#undef PG8_WAIT_V
#undef PG8_WAIT_L
#undef PG8_BAR
#undef PG8_SCHED
}
}

__device__ __forceinline__ void qkt(f32x16& p0, f32x16& p1, LAS const unsigned char* kslot, const bf16x8 (&qr)[4], int r32, int hi) {
    p0 = (f32x16){}; p1 = (f32x16){};
#pragma unroll
    for (int d0 = 0; d0 < 4; ++d0) {
        LAS const unsigned char* kb = kslot + (2 * d0 + hi) * 1024 + ((r32 ^ (2 * d0 + hi)) * 16); asm volatile("" : "+v"(kb));
        const bf16x8 b0 = *(LAS const bf16x8*)(kb);
        const bf16x8 b1 = *(LAS const bf16x8*)(kb + 512);
        p0 = __builtin_amdgcn_mfma_f32_32x32x16_bf16(b0, qr[d0], p0, 0, 0, 0);
        p1 = __builtin_amdgcn_mfma_f32_32x32x16_bf16(b1, qr[d0], p1, 0, 0, 0);
    }
}
__device__ __forceinline__ s16x4 vtr(LAS const unsigned char* p) { return __builtin_bit_cast(s16x4, __builtin_amdgcn_ds_read_tr16_b64_v4i16((LAS s16x4*)p)); }
__device__ __forceinline__ void pv(f32x16 (&o)[2], LAS const unsigned char* vp, const bf16x8 (&pa)[4]) {
    asm volatile("" : "+v"(vp));
#pragma unroll
    for (int d0 = 0; d0 < 2; ++d0)
#pragma unroll
        for (int ks = 0; ks < 4; ++ks) {
            const s16x4 lo = vtr(vp + d0 * 4096 + ks * 1024), hh = vtr(vp + d0 * 4096 + ks * 1024 + 512);
            const bf16x8 vf = (bf16x8){lo[0], lo[1], lo[2], lo[3], hh[0], hh[1], hh[2], hh[3]};
            o[d0] = __builtin_amdgcn_mfma_f32_32x32x16_bf16(pa[ks], vf, o[d0], 0, 0, 0);
        }
}
struct ModNone { __device__ __forceinline__ void apply(f32x16&, f32x16&, int, int) const {} };
struct ModNA {
    int kcs; LAS const float* tl;
    __device__ __forceinline__ void apply(f32x16& p0, f32x16& p1, int, int) const {
#pragma unroll
        for (int r = 0; r < 16; ++r) { constexpr int dummy = 0; (void)dummy; const int cr = (r & 3) + 8 * (r >> 2);
            { const float v = p0[r] + tl[cr]; p0[r] = ((unsigned)(cr + kcs) < 16u) ? v : -INFINITY; }
            { const float v = p1[r] + tl[cr + 32]; p1[r] = ((unsigned)(cr + 32 + kcs) < 16u) ? v : -INFINITY; } }
    }
};
struct ModNAP {
    int kcs; LAS const float* tl; int U[8], C8[8];
    __device__ __forceinline__ void apply(f32x16& p0, f32x16& p1, int, int) const {
#pragma unroll
        for (int r = 0; r < 16; ++r) { const int gq = r >> 2, w = r & 3;
            { const float v = p0[r] + tl[U[gq] + w]; p0[r] = ((unsigned)(C8[gq] + w + kcs) < 16u) ? v : -INFINITY; }
            { const float v = p1[r] + tl[U[gq + 4] + w]; p1[r] = ((unsigned)(C8[gq + 4] + w + kcs) < 16u) ? v : -INFINITY; } }
    }
};
struct ModDil {
    float af, strf, limf, slope2, tqf, tqmS; bool inb;
    __device__ __forceinline__ void apply(f32x16& p0, f32x16& p1, int, int) const {
        if (inb) {
#pragma unroll
            for (int r = 0; r < 16; ++r) { const float cr = (float)((r & 3) + 8 * (r >> 2));
                { const float d = __builtin_fmaf(-cr, strf, af); const float v = __builtin_fmaf(-slope2, __builtin_fabsf(d), p0[r]); p0[r] = (__builtin_fabsf(d) <= limf) ? v : -INFINITY; }
                { const float d = __builtin_fmaf(-(cr + 32.f), strf, af); const float v = __builtin_fmaf(-slope2, __builtin_fabsf(d), p1[r]); p1[r] = (__builtin_fabsf(d) <= limf) ? v : -INFINITY; } }
        } else {
#pragma unroll
            for (int r = 0; r < 16; ++r) { const float cr = (float)((r & 3) + 8 * (r >> 2));
                { const float d = __builtin_fmaf(-cr, strf, af); const float v = __builtin_fmaf(-slope2, __builtin_fabsf(d), p0[r]); p0[r] = ((__builtin_fabsf(d) <= limf) && (d <= tqf) && (d > tqmS)) ? v : -INFINITY; }
                { const float d = __builtin_fmaf(-(cr + 32.f), strf, af); const float v = __builtin_fmaf(-slope2, __builtin_fabsf(d), p1[r]); p1[r] = ((__builtin_fabsf(d) <= limf) && (d <= tqf) && (d > tqmS)) ? v : -INFINITY; } }
        }
    }
};
template <class Mod>
__device__ __forceinline__ void flash_step(LAS const unsigned char* kslot, LAS const unsigned char* vslot, const bf16x8 (&qr)[4], f32x16 (&o)[2], float& m, float& l, LAS float* wsf, int lane, const Mod& mod) {
    const int r32 = lane & 31, hi = lane >> 5;
    f32x16 p0, p1; qkt(p0, p1, kslot, qr, r32, hi);
    mod.apply(p0, p1, r32, hi);
    float rm = fmaxf(p0[0], p1[0]);
#pragma unroll
    for (int r = 1; r < 16; ++r) rm = fmaxf(rm, fmaxf(p0[r], p1[r]));
    rm = fmaxf(rm, __shfl_xor(rm, 32));
    const float mn = fmaxf(m, rm); const float alpha = __builtin_amdgcn_exp2f(m - mn); m = mn;
    float s = 0.f;
#pragma unroll
    for (int r = 0; r < 16; ++r) { p0[r] = __builtin_amdgcn_exp2f(p0[r] - mn); p1[r] = __builtin_amdgcn_exp2f(p1[r] - mn); s += p0[r] + p1[r]; }
    l = l * alpha + s;
    { LAS float* ww = wsf + r32; asm volatile("" : "+v"(ww)); if (hi == 0) *ww = alpha; }
    asm volatile("" ::: "memory");
    LAS const float* wr_ = wsf + 4 * hi; asm volatile("" : "+v"(wr_));
#pragma unroll
    for (int k = 0; k < 4; ++k) { const f32x4 a = *(LAS const f32x4*)(wr_ + 8 * k);
#pragma unroll
        for (int j = 0; j < 4; ++j) { o[0][4 * k + j] *= a[j]; o[1][4 * k + j] *= a[j]; } }
    bf16x8 pa[4];
    { u32x4 w;
      w = (u32x4){cvtpk(p0[0], p0[1]), cvtpk(p0[2], p0[3]), cvtpk(p0[4], p0[5]), cvtpk(p0[6], p0[7])}; pa[0] = __builtin_bit_cast(bf16x8, w);
      w = (u32x4){cvtpk(p0[8], p0[9]), cvtpk(p0[10], p0[11]), cvtpk(p0[12], p0[13]), cvtpk(p0[14], p0[15])}; pa[1] = __builtin_bit_cast(bf16x8, w);
      w = (u32x4){cvtpk(p1[0], p1[1]), cvtpk(p1[2], p1[3]), cvtpk(p1[4], p1[5]), cvtpk(p1[6], p1[7])}; pa[2] = __builtin_bit_cast(bf16x8, w);
      w = (u32x4){cvtpk(p1[8], p1[9]), cvtpk(p1[10], p1[11]), cvtpk(p1[12], p1[13]), cvtpk(p1[14], p1[15])}; pa[3] = __builtin_bit_cast(bf16x8, w); }
    const int vb = ((lane >> 4) & 1) * 32 + (lane & 3) * 8 + (4 * hi + ((lane & 15) >> 2)) * 64;
    pv(o, vslot + vb, pa);
}
template <class Mod>
__device__ __forceinline__ void flash_scores(LAS const unsigned char* kslot, const bf16x8 (&qr)[4], f32x16 (&o)[2], float& m, float& l, LAS float* wsf, int lane, const Mod& mod, bf16x8 (&pa)[4]) {
    const int r32 = lane & 31, hi = lane >> 5;
    f32x16 p0, p1; qkt(p0, p1, kslot, qr, r32, hi);
    mod.apply(p0, p1, r32, hi);
    float rm = fmaxf(p0[0], p1[0]);
#pragma unroll
    for (int r = 1; r < 16; ++r) rm = fmaxf(rm, fmaxf(p0[r], p1[r]));
    rm = fmaxf(rm, __shfl_xor(rm, 32));
    const float mn = fmaxf(m, rm); const float alpha = __builtin_amdgcn_exp2f(m - mn); m = mn;
    float s = 0.f;
#pragma unroll
    for (int r = 0; r < 16; ++r) { p0[r] = __builtin_amdgcn_exp2f(p0[r] - mn); p1[r] = __builtin_amdgcn_exp2f(p1[r] - mn); s += p0[r] + p1[r]; }
    l = l * alpha + s;
    { LAS float* ww = wsf + r32; asm volatile("" : "+v"(ww)); if (hi == 0) *ww = alpha; }
    asm volatile("" ::: "memory");
    LAS const float* wr_ = wsf + 4 * hi; asm volatile("" : "+v"(wr_));
#pragma unroll
    for (int k = 0; k < 4; ++k) { const f32x4 a = *(LAS const f32x4*)(wr_ + 8 * k);
#pragma unroll
        for (int j = 0; j < 4; ++j) { o[0][4 * k + j] *= a[j]; o[1][4 * k + j] *= a[j]; } }
    { u32x4 w;
      w = (u32x4){cvtpk(p0[0], p0[1]), cvtpk(p0[2], p0[3]), cvtpk(p0[4], p0[5]), cvtpk(p0[6], p0[7])}; pa[0] = __builtin_bit_cast(bf16x8, w);
      w = (u32x4){cvtpk(p0[8], p0[9]), cvtpk(p0[10], p0[11]), cvtpk(p0[12], p0[13]), cvtpk(p0[14], p0[15])}; pa[1] = __builtin_bit_cast(bf16x8, w);
      w = (u32x4){cvtpk(p1[0], p1[1]), cvtpk(p1[2], p1[3]), cvtpk(p1[4], p1[5]), cvtpk(p1[6], p1[7])}; pa[2] = __builtin_bit_cast(bf16x8, w);
      w = (u32x4){cvtpk(p1[8], p1[9]), cvtpk(p1[10], p1[11]), cvtpk(p1[12], p1[13]), cvtpk(p1[14], p1[15])}; pa[3] = __builtin_bit_cast(bf16x8, w); }
    asm volatile("" : "+v"(pa[0]), "+v"(pa[1]), "+v"(pa[2]), "+v"(pa[3]) :: "memory");
}
__device__ __forceinline__ void pv_lane(f32x16 (&o)[2], LAS const unsigned char* vslot, const bf16x8 (&pa)[4], int lane) {
    const int hi = lane >> 5;
    const int vb = ((lane >> 4) & 1) * 32 + (lane & 3) * 8 + (4 * hi + ((lane & 15) >> 2)) * 64;
    pv(o, vslot + vb, pa);
}
__device__ __forceinline__ float max3f(float a, float b, float c) { float r; asm("v_max3_f32 %0, %1, %2, %3" : "=v"(r) : "v"(a), "v"(b), "v"(c)); return r; }
__device__ __forceinline__ float rowmax32(const f32x16& p0, const f32x16& p1) {
    float a = max3f(p0[0], p0[1], p1[0]), b = max3f(p0[2], p0[3], p1[1]); a = max3f(a, p1[2], p1[3]);
#pragma unroll
    for (int r = 4; r < 16; r += 4) { a = max3f(a, p0[r], p0[r + 1]); b = max3f(b, p0[r + 2], p0[r + 3]); a = max3f(a, p1[r], p1[r + 1]); b = max3f(b, p1[r + 2], p1[r + 3]); }
    return fmaxf(a, b);
}
constexpr float THRL = 8.f;
__device__ __forceinline__ void qkt2(f32x16& p0, f32x16& p1, LAS const unsigned char* kslot, const bf16x8 (&qr)[4], const f32x16& negm, int r32, int hi) {
#pragma unroll
    for (int d0 = 0; d0 < 4; ++d0) {
        LAS const unsigned char* kb = kslot + (2 * d0 + hi) * 1024 + ((r32 ^ (2 * d0 + hi)) * 16); asm volatile("" : "+v"(kb));
        const bf16x8 b0 = *(LAS const bf16x8*)(kb);
        const bf16x8 b1 = *(LAS const bf16x8*)(kb + 512);
        if (d0 == 0) { p0 = __builtin_amdgcn_mfma_f32_32x32x16_bf16(b0, qr[0], negm, 0, 0, 0); p1 = __builtin_amdgcn_mfma_f32_32x32x16_bf16(b1, qr[0], negm, 0, 0, 0); }
        else { p0 = __builtin_amdgcn_mfma_f32_32x32x16_bf16(b0, qr[d0], p0, 0, 0, 0); p1 = __builtin_amdgcn_mfma_f32_32x32x16_bf16(b1, qr[d0], p1, 0, 0, 0); }
    }
}
template <bool HASNEXT, class Mod>
__device__ __forceinline__ void softmax2(f32x16& p0, f32x16& p1, f32x16 (&o)[2], f32x16& negm, float& mref, float& l, LAS float* wsf, int lane, const Mod& mod, bf16x8 (&pa)[4], f32x16& n0, f32x16& n1) {
    const int r32 = lane & 31, hi = lane >> 5;
    mod.apply(p0, p1, r32, hi);
    float rm = rowmax32(p0, p1);
    if (__builtin_expect(__any(rm > THRL), 0)) {
        rm = fmaxf(rm, __shfl_xor(rm, 32));
        const float dl = fmaxf(rm, 0.f);
        mref += dl;
#pragma unroll
        for (int r = 0; r < 16; ++r) { p0[r] -= dl; p1[r] -= dl; }
        if (HASNEXT) {
#pragma unroll
            for (int r = 0; r < 16; ++r) { n0[r] -= dl; n1[r] -= dl; } }
#pragma unroll
        for (int r = 0; r < 16; ++r) negm[r] = -mref;
        const float f = __builtin_amdgcn_exp2f(-dl); l *= f;
        { LAS float* ww = wsf + r32; asm volatile("" : "+v"(ww)); if (hi == 0) *ww = f; }
        asm volatile("" ::: "memory");
        LAS const float* wr_ = wsf + 4 * hi; asm volatile("" : "+v"(wr_));
#pragma unroll
        for (int k = 0; k < 4; ++k) { const f32x4 a = *(LAS const f32x4*)(wr_ + 8 * k);
#pragma unroll
            for (int j = 0; j < 4; ++j) { o[0][4 * k + j] *= a[j]; o[1][4 * k + j] *= a[j]; } }
    }
    float s = 0.f;
#pragma unroll
    for (int r = 0; r < 16; ++r) { p0[r] = __builtin_amdgcn_exp2f(p0[r]); p1[r] = __builtin_amdgcn_exp2f(p1[r]); s += p0[r] + p1[r]; }
    l += s;
    { u32x4 w;
      w = (u32x4){cvtpk(p0[0], p0[1]), cvtpk(p0[2], p0[3]), cvtpk(p0[4], p0[5]), cvtpk(p0[6], p0[7])}; pa[0] = __builtin_bit_cast(bf16x8, w);
      w = (u32x4){cvtpk(p0[8], p0[9]), cvtpk(p0[10], p0[11]), cvtpk(p0[12], p0[13]), cvtpk(p0[14], p0[15])}; pa[1] = __builtin_bit_cast(bf16x8, w);
      w = (u32x4){cvtpk(p1[0], p1[1]), cvtpk(p1[2], p1[3]), cvtpk(p1[4], p1[5]), cvtpk(p1[6], p1[7])}; pa[2] = __builtin_bit_cast(bf16x8, w);
      w = (u32x4){cvtpk(p1[8], p1[9]), cvtpk(p1[10], p1[11]), cvtpk(p1[12], p1[13]), cvtpk(p1[14], p1[15])}; pa[3] = __builtin_bit_cast(bf16x8, w); }
}
__device__ __forceinline__ void flash_finish(f32x16 (&o)[2], float l, LAS float* wsf, LAS unsigned char* stg, bf16_t* Obase, size_t qstride, int lane) {
    asm volatile("" : "+v"(lane));
    const int r32 = lane & 31, hi = lane >> 5;
    l += __shfl_xor(l, 32);
    { LAS float* ww = wsf + 32 + r32; asm volatile("" : "+v"(ww)); if (hi == 0) *ww = l; }
    asm volatile("" ::: "memory");
    LAS const float* wr_ = wsf + 32 + 4 * hi; asm volatile("" : "+v"(wr_));
    LAS bf16_t* st = (LAS bf16_t*)stg + (4 * hi) * 64 + r32; asm volatile("" : "+v"(st));
#pragma unroll
    for (int k = 0; k < 4; ++k) { const f32x4 a = *(LAS const f32x4*)(wr_ + 8 * k);
#pragma unroll
        for (int j = 0; j < 4; ++j) { const float rl = __builtin_amdgcn_rcpf(a[j]);
            st[(j + 8 * k) * 64] = (bf16_t)(cvtpk(o[0][4 * k + j] * rl, 0.f) & 0xffffu);
            st[(j + 8 * k) * 64 + 32] = (bf16_t)(cvtpk(o[1][4 * k + j] * rl, 0.f) & 0xffffu); } }
    asm volatile("" ::: "memory");
    LAS const bf16_t* sr = (LAS const bf16_t*)stg + (lane >> 3) * 64 + (lane & 7) * 8; asm volatile("" : "+v"(sr));
    bf16_t* op = Obase + (size_t)(lane >> 3) * qstride + (lane & 7) * 8;
#pragma unroll
    for (int i = 0; i < 4; ++i) { const u32x4 v = *(LAS const u32x4*)(sr + i * 8 * 64);
        *(u32x4*)(op + (size_t)(i * 8) * qstride) = v; }
}

__device__ __forceinline__ void flash_finish_c(f32x16 (&o)[2], float l, float mref, LAS float* wsf, LAS unsigned char* stg, bf16_t* Obase, size_t qstride, int lane, float* lse0, int lstep, bool merge) {
    asm volatile("" : "+v"(lane));
    const int r32 = lane & 31, hi = lane >> 5;
    float* lsep = lse0 + (size_t)r32 * lstep;
    bf16_t* op = Obase + (size_t)(lane >> 3) * qstride + (lane & 7) * 8;
    u32x4 gpre[4]; float lse1 = 0.f;
    if (merge) { lse1 = *lsep;
#pragma unroll
        for (int i = 0; i < 4; ++i) gpre[i] = *(const u32x4*)(op + (size_t)(i * 8) * qstride); }
    l += __shfl_xor(l, 32);
    const float lse2 = mref + __builtin_amdgcn_logf(l);
    float fa = 0.f, rl = __builtin_amdgcn_rcpf(l);
    if (merge) { const float M = fmaxf(lse1, lse2); const float w1 = __builtin_amdgcn_exp2f(lse1 - M), w2 = __builtin_amdgcn_exp2f(lse2 - M); const float inv = __builtin_amdgcn_rcpf(w1 + w2); fa = w1 * inv; rl = w2 * inv * rl; }
    else if (hi == 0) *lsep = lse2;
    { LAS float* ww = wsf + r32; asm volatile("" : "+v"(ww)); if (hi == 0) { ww[0] = fa; ww[32] = rl; } }
    asm volatile("" ::: "memory");
    LAS const float* wr_ = wsf + 32 + 4 * hi; asm volatile("" : "+v"(wr_));
    LAS bf16_t* st = (LAS bf16_t*)stg + (4 * hi) * 64 + r32; asm volatile("" : "+v"(st));
#pragma unroll
    for (int k = 0; k < 4; ++k) { const f32x4 a = *(LAS const f32x4*)(wr_ + 8 * k);
#pragma unroll
        for (int j = 0; j < 4; ++j) {
            st[(j + 8 * k) * 64] = (bf16_t)(cvtpk(o[0][4 * k + j] * a[j], 0.f) & 0xffffu);
            st[(j + 8 * k) * 64 + 32] = (bf16_t)(cvtpk(o[1][4 * k + j] * a[j], 0.f) & 0xffffu); } }
    asm volatile("" ::: "memory");
    LAS const bf16_t* sr = (LAS const bf16_t*)stg + (lane >> 3) * 64 + (lane & 7) * 8; asm volatile("" : "+v"(sr));
    LAS const float* fr_ = wsf + (lane >> 3); asm volatile("" : "+v"(fr_));
#pragma unroll
    for (int i = 0; i < 4; ++i) { u32x4 v = *(LAS const u32x4*)(sr + i * 8 * 64);
        if (merge) { const float f = fr_[i * 8]; const u32x4 g = gpre[i];
            v.x = cvtpk(__builtin_fmaf(f, __builtin_bit_cast(float, g.x << 16), __builtin_bit_cast(float, v.x << 16)), __builtin_fmaf(f, __builtin_bit_cast(float, g.x & 0xffff0000u), __builtin_bit_cast(float, v.x & 0xffff0000u)));
            v.y = cvtpk(__builtin_fmaf(f, __builtin_bit_cast(float, g.y << 16), __builtin_bit_cast(float, v.y << 16)), __builtin_fmaf(f, __builtin_bit_cast(float, g.y & 0xffff0000u), __builtin_bit_cast(float, v.y & 0xffff0000u)));
            v.z = cvtpk(__builtin_fmaf(f, __builtin_bit_cast(float, g.z << 16), __builtin_bit_cast(float, v.z << 16)), __builtin_fmaf(f, __builtin_bit_cast(float, g.z & 0xffff0000u), __builtin_bit_cast(float, v.z & 0xffff0000u)));
            v.w = cvtpk(__builtin_fmaf(f, __builtin_bit_cast(float, g.w << 16), __builtin_bit_cast(float, v.w << 16)), __builtin_fmaf(f, __builtin_bit_cast(float, g.w & 0xffff0000u), __builtin_bit_cast(float, v.w & 0xffff0000u))); }
        *(u32x4*)(op + (size_t)(i * 8) * qstride) = v; }
}

#define XB_TMO      128
#define XB_XCNT(j)  (256  + 64 * (j))
#define XB_XSUB(j)  (1280 + 64 * (j))
#define XB_XGEN(j)  (2304 + 64 * (j))
#define XB_TOP      3328
#define XB_TOPGEN   3392
#define XCD_BAR_WORDS 3456
#define XB_SPIN_CAP (1u << 22)
__device__ __forceinline__ unsigned xb_ld(unsigned* p)              { return __hip_atomic_load(p, __ATOMIC_RELAXED, __HIP_MEMORY_SCOPE_AGENT); }
__device__ __forceinline__ unsigned xb_add(unsigned* p, unsigned v) { return __hip_atomic_fetch_add(p, v, __ATOMIC_RELAXED, __HIP_MEMORY_SCOPE_AGENT); }
__device__ __forceinline__ unsigned xb_xcc_id() { return (unsigned)__builtin_amdgcn_s_getreg((3 << 11) | 20) & 0xFu; }
#define XB_SPIN(cond, bar) do { unsigned _sp = 0; while (cond) { __builtin_amdgcn_s_sleep(1); \
    if ((++_sp & 255u) == 0u) { if (xb_ld(&(bar)[XB_TMO])) break; if (_sp > XB_SPIN_CAP) { atomicAdd(&(bar)[XB_TMO], 1u); break; } } } } while (0)
struct XcdBarrier { unsigned* bar; unsigned x; volatile LAS unsigned* st; };
__device__ __forceinline__ XcdBarrier xcd_barrier_post(unsigned* bar, volatile LAS unsigned* st) {
    XcdBarrier b; b.bar = bar; b.x = xb_xcc_id(); b.st = st;
    if (threadIdx.x == 0) (void)xb_add(&bar[XB_XCNT(b.x)], 1u);
    return b;
}
__device__ __forceinline__ void xcd_barrier_complete(unsigned* bar, unsigned x, unsigned& nloc, unsigned& nx) {
    const unsigned G = gridDim.x * gridDim.y * gridDim.z;
    unsigned sum, cnt, mine, sp = 0u;
    for (;;) {
        sum = 0u; cnt = 0u; mine = 0u;
#pragma unroll
        for (unsigned j = 0; j < 16; ++j) { const unsigned c = xb_ld(&bar[XB_XCNT(j)]); sum += c; cnt += (c > 0u) ? 1u : 0u; mine = (j == x) ? c : mine; }
        if (sum == G) break;
        __builtin_amdgcn_s_sleep(1);
        if ((++sp & 255u) == 0u) { if (xb_ld(&bar[XB_TMO])) break; if (sp > XB_SPIN_CAP) { atomicAdd(&bar[XB_TMO], 1u); break; } }
    }
    nloc = mine > 0u ? mine : 1u; nx = cnt > 0u ? cnt : 1u;
}
__device__ __forceinline__ void xcd_barrier(const XcdBarrier& b) {
    asm volatile("s_waitcnt vmcnt(0)" ::: "memory");
    __syncthreads();
    if (threadIdx.x == 0) {
        unsigned* bar = b.bar; asm volatile("" : "+s"(bar));
        __builtin_amdgcn_s_waitcnt(0);
        unsigned nloc = b.st[0], nx = b.st[1];
        if (nloc == 0u) { xcd_barrier_complete(bar, b.x, nloc, nx); b.st[0] = nloc; b.st[1] = nx; }
        const unsigned old = xb_add(&bar[XB_XSUB(b.x)], 1u);
        const unsigned gen = old / nloc;
        if (old + 1u == (gen + 1u) * nloc) {
            __builtin_amdgcn_fence(__ATOMIC_RELEASE, "agent");
            asm volatile("s_waitcnt vmcnt(0)" ::: "memory");
            const unsigned og = xb_add(&bar[XB_TOP], 1u);
            const unsigned tg = og / nx;
            if (og + 1u == (tg + 1u) * nx) xb_add(&bar[XB_TOPGEN], 1u);
            else XB_SPIN(xb_ld(&bar[XB_TOPGEN]) == tg, bar);
            __builtin_amdgcn_fence(__ATOMIC_ACQUIRE, "agent");
            xb_add(&bar[XB_XGEN(b.x)], 1u);
            asm volatile("s_waitcnt vmcnt(0)" ::: "memory");
        } else {
            XB_SPIN(xb_ld(&bar[XB_XGEN(b.x)]) == gen, bar);
            __builtin_amdgcn_fence(__ATOMIC_ACQUIRE, "agent");
            asm volatile("s_waitcnt vmcnt(0)" ::: "memory");
        }
    }
    __syncthreads();
}

__device__ __forceinline__ u32x4 prep_item(const u32x4 raw, const float* gn, const f32x2* rope, int pr, int pc, int cc, float sc) {
    float y[8]; y[0] = bf2f(raw.x & 0xffff); y[1] = bf2f(raw.x >> 16); y[2] = bf2f(raw.y & 0xffff); y[3] = bf2f(raw.y >> 16); y[4] = bf2f(raw.z & 0xffff); y[5] = bf2f(raw.z >> 16); y[6] = bf2f(raw.w & 0xffff); y[7] = bf2f(raw.w >> 16);
    float sq = 0.f;
#pragma unroll
    for (int j = 0; j < 8; ++j) sq += y[j] * y[j];
    sq += __shfl_xor(sq, 1); sq += __shfl_xor(sq, 2); sq += __shfl_xor(sq, 4);
    const float rn = __builtin_amdgcn_rsqf(sq * (1.f / 64.f) + EPS);
    const int pos = (cc >> 2) ? pc : pr; const f32x2* tb = rope + pos * 16 + (cc & 1) * 8; const bool first = (cc & 3) < 2;
    float ov[8];
#pragma unroll
    for (int j = 0; j < 8; ++j) { const float yy = y[j] * rn * gn[j]; const float py = __shfl_xor(yy, 2); const f32x2 cs = tb[j];
        ov[j] = (first ? (yy * cs.x - py * cs.y) : (py * cs.y + yy * cs.x)) * sc; }
    return (u32x4){cvtpk(ov[0], ov[1]), cvtpk(ov[2], ov[3]), cvtpk(ov[4], ov[5]), cvtpk(ov[6], ov[7])};
}

struct Params { const float* in[14]; float* out; unsigned char* ws; };

__device__ __forceinline__ void transpose_item(const float* W, int K, int N, bf16_t* WT, const float* gain, int mode, LAS float* scr, int item, int lane) {
    asm volatile("" : "+v"(lane));
    const int nblk = N / 32, kb = item / nblk, nb = item % nblk, k0 = 64 * kb, n0 = 32 * nb;
#pragma unroll 8
    for (int i = 0; i < 32; ++i) { const int kk = 2 * i + (lane >> 5); float w = __builtin_nontemporal_load(W + (size_t)(k0 + kk) * N + n0 + (lane & 31)); if (gain) w *= gain[k0 + kk]; scr[kk * 33 + (lane & 31)] = w; }
    int d0 = n0;
    if (mode == 1) { const int j = n0 < DFF ? n0 : n0 - DFF; d0 = 256 * (j >> 7) + (j & 127) + (n0 < DFF ? 0 : 128); }
    const int c = lane & 7;
#pragma unroll
    for (int j = 0; j < 4; ++j) { const int n = (lane >> 3) + 8 * j; const LAS float* s = scr + (8 * c) * 33 + n;
        u32x4 o; o.x = cvtpk(s[0 * 33], s[1 * 33]); o.y = cvtpk(s[2 * 33], s[3 * 33]); o.z = cvtpk(s[4 * 33], s[5 * 33]); o.w = cvtpk(s[6 * 33], s[7 * 33]);
        *(u32x4*)(WT + (size_t)(d0 + n) * K + k0 + 8 * c) = o; }
}

__global__ void __launch_bounds__(NTHREADS) fwd_megakernel(Params P) {
#define GAS __attribute__((address_space(1)))
#define KA(i) ((const float*)(const GAS float*)ka[(i)])
    extern __shared__ __attribute__((aligned(16))) unsigned char lds_raw[];
    cg::grid_group grid = cg::this_grid();
    LAS unsigned char* lds = (LAS unsigned char*)lds_raw;
    const int tid0 = threadIdx.x, wave = __builtin_amdgcn_readfirstlane(tid0 >> 6);
    const int G0 = gridDim.x, bx0 = blockIdx.x;
    const int vcu0 = (G0 % 8 == 0) ? (bx0 % 8) * (G0 / 8) + bx0 / 8 : bx0;
    LAS float* wsf = (LAS float*)(lds + WSF_OFF) + wave * 64;
    volatile LAS unsigned* bst = (volatile LAS unsigned*)(lds + PTAB_OFF);
    if (tid0 < 2) bst[tid0] = 0u;
    __syncthreads();
    XcdBarrier xbar = xcd_barrier_post((unsigned*)(P.ws + WS_BAR), bst);

    for (int ph = 0; ph <= 24; ++ph) {
        const __attribute__((address_space(4))) unsigned long long* ka = (const __attribute__((address_space(4))) unsigned long long*)__builtin_amdgcn_kernarg_segment_ptr(); asm volatile("" : "+s"(ka));
        unsigned char* ws = (unsigned char*)(GAS unsigned char*)ka[15];
        f32x2* rope = (f32x2*)(ws + WS_ROPE);
        float* ssq_all = (float*)(ws + WS_SSQ);
        bf16_t* QKV = (bf16_t*)(ws + WS_QKV); bf16_t* HB = (bf16_t*)(ws + WS_H); bf16_t* OB = (bf16_t*)(ws + WS_O);
        int G = G0, bx = bx0, vcu = vcu0; asm volatile("" : "+s"(G), "+s"(bx), "+s"(vcu));
        const int gw = vcu * NWAVES + wave, NGW = G * NWAVES;
        int tid = tid0; asm volatile("" : "+v"(tid));
        const int lane = tid & 63, r32 = lane & 31, hi = lane >> 5;
        const int c = ph / 12, s = ph % 12;
        const int S = (c == 0) ? 8192 : 4096, nb = RC / S;
        const float* xin = KA(c & 1);
        float* xout = ((float*)(GAS float*)ka[14]) + (size_t)(c & 1) * RC * DM;
        float* ssq = ssq_all + (size_t)(c & 1) * 5 * RC;
        bf16_t* XB = (bf16_t*)(ws + ((c & 1) ? WS_XB1 : WS_XB));
        if (s == 0) {
            if (ph == 0 && (PHM & 1)) {
                LAS float* scr = (LAS float*)(lds + wave * 16384);
                constexpr int I0 = 16 * (NE / 32), I1 = 16 * (DM / 32), I2 = 16 * (NO / 32), I3 = I1, I4 = 16 * (NGU / 32), I5 = I4, I6 = (DFF / 64) * (DM / 32), I7 = I6;
                constexpr int NIT = I0 + I1 + I2 + I3 + I4 + I5 + I6 + I7;
                for (int it = gw; it < NIT; it += NGW) {
                    int r = it;
                    if (r < I0) { transpose_item(KA(5), DM, NE, (bf16_t*)(ws + W_INE), KA(2), 0, scr, r, lane); continue; } r -= I0;
                    if (r < I1) { transpose_item(KA(9), DM, DM, (bf16_t*)(ws + W_OUTE), nullptr, 0, scr, r, lane); continue; } r -= I1;
                    if (r < I2) { transpose_item(KA(10), DM, NO, (bf16_t*)(ws + W_INO), KA(2) + DM, 0, scr, r, lane); continue; } r -= I2;
                    if (r < I3) { transpose_item(KA(11), DM, DM, (bf16_t*)(ws + W_OUTO), nullptr, 0, scr, r, lane); continue; } r -= I3;
                    if (r < I4) { transpose_item(KA(12), DM, NGU, (bf16_t*)(ws + W_GU0), KA(3), 1, scr, r, lane); continue; } r -= I4;
                    if (r < I5) { transpose_item(KA(12) + (size_t)DM * NGU, DM, NGU, (bf16_t*)(ws + W_GU1), KA(3) + DM, 1, scr, r, lane); continue; } r -= I5;
                    if (r < I6) { transpose_item(KA(13), DFF, DM, (bf16_t*)(ws + W_DN0), nullptr, 0, scr, r, lane); continue; } r -= I6;
                    transpose_item(KA(13) + (size_t)DFF * DM, DFF, DM, (bf16_t*)(ws + W_DN1), nullptr, 0, scr, r, lane);
                }
                const int gt = vcu * NTHREADS + tid;
                if (gt < 2048) { const int pos = gt >> 4, i = gt & 15; const float fr = __builtin_amdgcn_exp2f(-(float)i * (13.287712379549449f / 16.f)); const float ang = (float)pos * fr;
                    float sn, cs; sincosf(ang, &sn, &cs); rope[gt] = (f32x2){cs, sn}; }
            }
            if (c >= 1) {
                float* po = ((float*)(GAS float*)ka[14]) + (size_t)(c - 1) * RC * DM; const float* pq = ssq_all + (size_t)(c - 1) * 5 * RC + 4 * RC; const float* gf = KA(4);
                const bf16_t* xp = (const bf16_t*)(ws + (((c - 1) & 1) ? WS_XB1 : WS_XB));
                for (int row = gw; row < RC; row += NGW) { const float rs = __builtin_amdgcn_rsqf(pq[row] * (1.f / DM) + EPS);
#pragma unroll
                    for (int hf = 0; hf < 2; ++hf) { const u32x4 r = __builtin_nontemporal_load((const u32x4*)(xp + (size_t)row * DM + hf * 512 + lane * 8));
                        const f32x4 g0 = *(const f32x4*)(gf + hf * 512 + lane * 8), g1 = *(const f32x4*)(gf + hf * 512 + lane * 8 + 4);
                        f32x4 y0, y1;
                        y0[0] = __builtin_bit_cast(float, r.x << 16); y0[1] = __builtin_bit_cast(float, r.x & 0xffff0000u); y0[2] = __builtin_bit_cast(float, r.y << 16); y0[3] = __builtin_bit_cast(float, r.y & 0xffff0000u);
                        y1[0] = __builtin_bit_cast(float, r.z << 16); y1[1] = __builtin_bit_cast(float, r.z & 0xffff0000u); y1[2] = __builtin_bit_cast(float, r.w << 16); y1[3] = __builtin_bit_cast(float, r.w & 0xffff0000u);
                        f32x4* op = (f32x4*)(po + (size_t)row * DM + hf * 512 + lane * 8);
                        __builtin_nontemporal_store(y0 * rs * g0, op); __builtin_nontemporal_store(y1 * rs * g1, op + 1); } }
            }
            if (c < 2) {
                for (int row = gw; row < RC; row += NGW) { const f32x4* xr = (const f32x4*)(xin + (size_t)row * DM) + lane; f32x4 v[4]; float sq = 0.f;
#pragma unroll
                    for (int j = 0; j < 4; ++j) { v[j] = __builtin_nontemporal_load(xr + 64 * j); sq += (v[j].x * v[j].x + v[j].y * v[j].y) + (v[j].z * v[j].z + v[j].w * v[j].w); }
                    sq = wave_sum(sq); u32x2* o8 = (u32x2*)(XB + (size_t)row * DM) + lane;
#pragma unroll
                    for (int j = 0; j < 4; ++j) o8[64 * j] = (u32x2){cvtpk(v[j].x, v[j].y), cvtpk(v[j].z, v[j].w)};
                    if (lane < 5) ssq[(size_t)lane * RC + row] = lane == 0 ? sq : 0.f; }
            }
        } else if ((s == 1 || s == 7) && (PHM & 2)) {
            const int N = (s == 1) ? NE : NO;
            pg8::Gemm g{XB, (const bf16_t*)(ws + (s == 1 ? W_INE : W_INO)), RC, N, DM}; pg8::StaticOrder SO; SO.init(RC, N, G, bx);
            pg8::EpiScaleBf16 E{QKV, (s == 1) ? NEP : NOP, ssq + (s == 1 ? 0 : 2) * (size_t)RC, (s == 1) ? 3 : 0, (s == 1) ? 5 : 4, C2};
            for (int rep = 0; rep < ((DUP & 4) ? 2 : 1); ++rep) pg8::gemm_phase<pg8::EpiScaleBf16>(lds, g, SO, E, wave);
        } else if ((s == 4 || s == 6 || s == 9 || s == 11) && (PHM & 4)) {
            const bool dn = (s == 6 || s == 11); const int K = dn ? DFF : DM;
            const size_t woff = (s == 4) ? W_OUTE : (s == 6) ? W_DN0 : (s == 9) ? W_OUTO : W_DN1;
            pg8::Gemm g{dn ? HB : OB, (const bf16_t*)(ws + woff), RC, DM, K}; pg8::StaticOrder SO; SO.init(RC, DM, G, bx);
            const int qi = (s == 4) ? 1 : (s == 6) ? 2 : (s == 9) ? 3 : 4;
            pg8::EpiResidual E{XB, ssq + (size_t)qi * RC};
            pg8::gemm_phase<pg8::EpiResidual>(lds, g, SO, E, wave);
        } else if ((s == 5 || s == 10) && (PHM & 8)) {
            pg8::Gemm g{XB, (const bf16_t*)(ws + (s == 5 ? W_GU0 : W_GU1)), RC, NGU, DM}; pg8::StaticOrder SO; SO.init(RC, NGU, G, bx);
            pg8::EpiSwiGLU E{HB, ssq + (size_t)(s == 5 ? 1 : 3) * RC};
            for (int rep = 0; rep < ((DUP & 4) ? 2 : 1); ++rep) pg8::gemm_phase<pg8::EpiSwiGLU>(lds, g, SO, E, wave);
        } else if (s == 2 && (PHM & 16)) {
            const float* gq = KA(6); const float* gk = KA(7);
            for (int grp = gw; grp < RC / 4; grp += NGW) {
                const int row0 = 4 * grp, cc = lane & 7;
                bf16_t* qptr = QKV + (size_t)row0 * NEP + (lane >> 3) * 64 + cc * 8;
                const int rsub = lane >> 4;
                bf16_t* kptr = QKV + (size_t)(row0 + rsub) * NEP + 512 + ((lane >> 3) & 1) * 64 + cc * 8;
                u32x4 rq[4];
#pragma unroll
                for (int q = 0; q < 4; ++q) rq[q] = *(const u32x4*)(qptr + (size_t)q * NEP);
                const u32x4 rk = *(const u32x4*)kptr;
#pragma unroll
                for (int q = 0; q < 4; ++q) { const int t = (row0 + q) & (S - 1); *(u32x4*)(qptr + (size_t)q * NEP) = prep_item(rq[q], gq + cc * 8, rope, t >> 6, t & 63, cc, C2); }
                { const int t = (row0 + rsub) & (S - 1); *(u32x4*)kptr = prep_item(rk, gk + cc * 8, rope, t >> 6, t & 63, cc, 1.f); }
            }
            { LAS float* tabL = (LAS float*)(lds + RPB_OFF); const float* rpb = KA(8);
              for (int i = tid; i < 3720; i += NTHREADS) tabL[i] = rpb[i] * LOG2E;
              __syncthreads();
              const int rows = S >> 6; const int ntask = nb * rows * 16;
              LAS unsigned char* wl = lds + wave * 16384;
              for (int rep = 0; rep < ((DUP & 2) ? 2 : 1); ++rep)
              for (int wt = gw; wt < ntask; wt += NGW) {
                  const int qh = wt & 1, h = (wt >> 1) & 7, br = wt >> 4, r = br % rows, b = br / rows;
                  const int rs0 = min(max(r - 4, 0), rows - 8);
                  const size_t rowbase = (size_t)b * S;
                  const int qc = qh * 32 + r32, cs = min(max(qc - 8, 0), 48);
                  const bf16_t* qp = QKV + (rowbase + r * 64 + qc) * NEP + 768 + h * 64 + hi * 8;
                  bf16x8 qr[4];
#pragma unroll
                  for (int d0 = 0; d0 < 4; ++d0) qr[d0] = *(const bf16x8*)(qp + d0 * 16);
                  f32x16 o[2]; o[0] = (f32x16){}; o[1] = (f32x16){}; f32x16 negm = (f32x16){}; float mref = 0.f, l = 0.f;
                  const int lrow = lane >> 3, ch = lane & 7;
                  const int lrowV = 2 * (lane >> 4) + ((lane >> 2) & 1), dhV = (lane >> 3) & 1, cwV = lane & 3;
                  const int cbase = 24 * qh;
                  const bf16_t* kp = QKV + (rowbase + (size_t)rs0 * 64 + cbase + lrow) * NEP + 1280 + h * 64 + ch * 8;
                  const bf16_t* vp = QKV + (rowbase + (size_t)rs0 * 64 + cbase + lrowV) * NEP + 1792 + h * 64 + dhV * 32 + cwV * 8;
                  u32x4 kr[8], vr[8];
#define NAP_LOAD(T_) do { _Pragma("unroll") for (int j = 0; j < 8; ++j) { const int g_ = 8 * (T_) + j, kr_ = (g_ * 205) >> 10, kc_ = g_ - 5 * kr_; const size_t off_ = (size_t)(kr_ * 64 + kc_ * 8) * NEP; \
                      kr[j] = *(const u32x4*)(kp + off_); vr[j] = *(const u32x4*)(vp + off_); } } while (0)
                  NAP_LOAD(0);
                  const int kcs = 4 * hi - cs;
                  for (int jt = 0; jt < 5; ++jt) {
                      LAS unsigned char* kw = wl + ch * 1024 + (lrow ^ ch) * 16; LAS unsigned char* vw = wl + 8192 + dhV * 4096 + lrowV * 64 + cwV * 16; asm volatile("" : "+v"(kw), "+v"(vw));
#pragma unroll
                      for (int j = 0; j < 8; ++j) { *(LAS u32x4*)(kw + j * 128) = kr[j]; *(LAS u32x4*)(vw + j * 512) = vr[j]; }
                      int kcs_ = kcs; asm volatile("" : "+v"(kcs_));
                      ModNAP mod; mod.kcs = kcs_; mod.tl = tabL + (15 - qc + 4 * hi);
#pragma unroll
                      for (int g = 0; g < 8; ++g) { const int g_ = 8 * jt + g, kr_ = (g_ * 205) >> 10, kc_ = g_ - 5 * kr_; mod.C8[g] = cbase + kc_ * 8; mod.U[g] = (h * 15 + (rs0 + kr_ - r + 7)) * 31 + cbase + kc_ * 8; }
                      bf16x8 pa[4];
                      if (jt + 1 < 5) NAP_LOAD(jt + 1);
                      f32x16 s0, s1;
                      qkt2(s0, s1, wl, qr, negm, r32, hi);
                      softmax2<false>(s0, s1, o, negm, mref, l, wsf, lane, mod, pa, s0, s1);
                      pv_lane(o, wl + 8192, pa, lane);
                      asm volatile("" ::: "memory");
                  }
#undef NAP_LOAD
                  flash_finish(o, l, wsf, wl, OB + (rowbase + r * 64 + qh * 32) * DM + 512 + h * 64, DM, lane);
              } }
        } else if (s == 3 && (PHM & 32)) {
            const int nqb = S >> 8, ntask = nb * 8 * nqb, NT = S >> 6;
            LAS unsigned char* stg = lds + 81920 + wave * 4096;
            float gqm = 0.f, gkm = 0.f;
            { const float* gq = KA(6); const float* gk = KA(7);
              for (int i = 0; i < 64; ++i) { gqm = fmaxf(gqm, __builtin_fabsf(gq[i])); gkm = fmaxf(gkm, __builtin_fabsf(gk[i])); } }
            const float sbound = 64.f * C2 * gqm * gkm * 1.001f;
            const bool fastA = sbound < 64.f;
            for (int rep = 0; rep < ((DUP & 1) ? 2 : 1); ++rep)
            for (int task = vcu; task < ntask; task += G) {
                const int qb = task % nqb, bh = task / nqb, h = bh & 7, b = bh >> 3;
                const size_t rowbase = (size_t)b * S;
                const int q0 = qb * 256 + wave * 32;
                const bf16_t* qp = QKV + (rowbase + q0 + r32) * NEP + h * 64 + hi * 8;
                bf16x8 qr[4];
#pragma unroll
                for (int d0 = 0; d0 < 4; ++d0) qr[d0] = *(const bf16x8*)(qp + d0 * 16);
                f32x16 o[2]; o[0] = (f32x16){}; o[1] = (f32x16){}; float l = 0.f;
                const int trow = wave * 8 + (lane >> 3), ch = lane & 7;
                const int trowV = wave * 8 + 2 * (lane >> 4) + ((lane >> 2) & 1), dhV = (lane >> 3) & 1, cwV = lane & 3;
                const bf16_t* kp = QKV + (rowbase + trow) * NEP + 512 + (h >> 2) * 64 + ch * 8;
                const bf16_t* vp = QKV + (rowbase + trowV) * NEP + 640 + (h >> 2) * 64 + dhV * 32 + cwV * 8;
                const unsigned kdst = ch * 1024 + (trow ^ ch) * 16, vdst = 8192 + dhV * 4096 + trowV * 64 + cwV * 16;
                u32x4 kreg = *(const u32x4*)kp, vreg = *(const u32x4*)vp;
                if (!fastA) {
                    float m = -1e30f;
                    *(LAS u32x4*)(lds + kdst) = kreg; *(LAS u32x4*)(lds + vdst) = vreg;
                    __syncthreads();
                    for (int t = 0; t < NT; ++t) {
                        const unsigned cur = (t & 1) * 16384u, nxt = 16384u - cur;
                        if (t + 1 < NT) { kreg = *(const u32x4*)(kp + (size_t)(t + 1) * 64 * NEP); vreg = *(const u32x4*)(vp + (size_t)(t + 1) * 64 * NEP); }
                        flash_step(lds + cur, lds + cur + 8192, qr, o, m, l, wsf, lane, ModNone{});
                        if (t + 1 < NT) { *(LAS u32x4*)(lds + nxt + kdst) = kreg; *(LAS u32x4*)(lds + nxt + vdst) = vreg; }
                        __syncthreads();
                    }
                    flash_finish(o, l, wsf, stg, OB + (rowbase + q0) * DM + h * 64, DM, lane);
                    continue;
                }
                u32x4 kreg1 = *(const u32x4*)(kp + (size_t)64 * NEP), vreg1 = *(const u32x4*)(vp + (size_t)64 * NEP);
                u32x4 kreg2 = *(const u32x4*)(kp + (size_t)128 * NEP), vreg2 = *(const u32x4*)(vp + (size_t)128 * NEP);
                *(LAS u32x4*)(lds + kdst) = kreg; *(LAS u32x4*)(lds + vdst) = vreg;
                *(LAS u32x4*)(lds + 16384 + kdst) = kreg1; *(LAS u32x4*)(lds + 16384 + vdst) = vreg1;
                *(LAS u32x4*)(lds + 32768 + kdst) = kreg2; *(LAS u32x4*)(lds + 32768 + vdst) = vreg2;
                __syncthreads();
                f32x16 sa0, sa1, sb0, sb1;
                { const f32x16 z_ = (f32x16){}; qkt2(sa0, sa1, lds, qr, z_, r32, hi); }
                unsigned bcur = 0, bnxt = 16384, bnn = 49152;
                const int vbl = ((lane >> 4) & 1) * 32 + (lane & 3) * 8 + (4 * hi + ((lane & 15) >> 2)) * 64;
#define A_SCHED __builtin_amdgcn_sched_barrier(0)
#define A_STEP(C0, C1, N0, N1, T_) do { \
                    if ((T_) + 3 < NT) { kreg = *(const u32x4*)(kp + (size_t)((T_) + 3) * 64 * NEP); vreg = *(const u32x4*)(vp + (size_t)((T_) + 3) * 64 * NEP); } \
                    bf16x8 kf[4], kg[4]; \
                    { _Pragma("unroll") for (int d0 = 0; d0 < 2; ++d0) { LAS const unsigned char* kb_ = lds + bnxt + (2 * d0 + hi) * 1024 + ((r32 ^ (2 * d0 + hi)) * 16); asm volatile("" : "+v"(kb_)); \
                        kf[2 * d0] = *(LAS const bf16x8*)(kb_); kf[2 * d0 + 1] = *(LAS const bf16x8*)(kb_ + 512); } } \
                    A_SCHED; \
                    { _Pragma("unroll") for (int d0 = 2; d0 < 4; ++d0) { LAS const unsigned char* kb_ = lds + bnxt + (2 * d0 + hi) * 1024 + ((r32 ^ (2 * d0 + hi)) * 16); asm volatile("" : "+v"(kb_)); \
                        kg[2 * d0 - 4] = *(LAS const bf16x8*)(kb_); kg[2 * d0 - 3] = *(LAS const bf16x8*)(kb_ + 512); } } \
                    N0 = __builtin_amdgcn_mfma_f32_32x32x16_bf16(kf[0], qr[0], (f32x16){}, 0, 0, 0); N1 = __builtin_amdgcn_mfma_f32_32x32x16_bf16(kf[1], qr[0], (f32x16){}, 0, 0, 0); \
                    N0 = __builtin_amdgcn_mfma_f32_32x32x16_bf16(kf[2], qr[1], N0, 0, 0, 0);   N1 = __builtin_amdgcn_mfma_f32_32x32x16_bf16(kf[3], qr[1], N1, 0, 0, 0); \
                    A_SCHED; \
                    N0 = __builtin_amdgcn_mfma_f32_32x32x16_bf16(kg[0], qr[2], N0, 0, 0, 0);   N1 = __builtin_amdgcn_mfma_f32_32x32x16_bf16(kg[1], qr[2], N1, 0, 0, 0); \
                    N0 = __builtin_amdgcn_mfma_f32_32x32x16_bf16(kg[2], qr[3], N0, 0, 0, 0);   N1 = __builtin_amdgcn_mfma_f32_32x32x16_bf16(kg[3], qr[3], N1, 0, 0, 0); \
                    A_SCHED; \
                    s16x4 vlo[4], vhi[4]; \
                    { LAS const unsigned char* vp_ = lds + bcur + 8192 + vbl; asm volatile("" : "+v"(vp_)); \
                      _Pragma("unroll") for (int i = 0; i < 4; ++i) { vlo[i] = vtr(vp_ + (i & 3) * 1024); vhi[i] = vtr(vp_ + (i & 3) * 1024 + 512); } } \
                    A_SCHED; \
                    float s_ = 0.f; \
                    _Pragma("unroll") for (int r = 0; r < 16; ++r) { C0[r] = __builtin_amdgcn_exp2f(C0[r]); C1[r] = __builtin_amdgcn_exp2f(C1[r]); s_ += C0[r] + C1[r]; } \
                    l += s_; \
                    bf16x8 pa[4]; \
                    { u32x4 w; \
                      w = (u32x4){cvtpk(C0[0], C0[1]), cvtpk(C0[2], C0[3]), cvtpk(C0[4], C0[5]), cvtpk(C0[6], C0[7])}; pa[0] = __builtin_bit_cast(bf16x8, w); \
                      w = (u32x4){cvtpk(C0[8], C0[9]), cvtpk(C0[10], C0[11]), cvtpk(C0[12], C0[13]), cvtpk(C0[14], C0[15])}; pa[1] = __builtin_bit_cast(bf16x8, w); \
                      w = (u32x4){cvtpk(C1[0], C1[1]), cvtpk(C1[2], C1[3]), cvtpk(C1[4], C1[5]), cvtpk(C1[6], C1[7])}; pa[2] = __builtin_bit_cast(bf16x8, w); \
                      w = (u32x4){cvtpk(C1[8], C1[9]), cvtpk(C1[10], C1[11]), cvtpk(C1[12], C1[13]), cvtpk(C1[14], C1[15])}; pa[3] = __builtin_bit_cast(bf16x8, w); } \
                    A_SCHED; \
                    _Pragma("unroll") for (int i = 0; i < 4; ++i) { const bf16x8 vf = (bf16x8){vlo[i][0], vlo[i][1], vlo[i][2], vlo[i][3], vhi[i][0], vhi[i][1], vhi[i][2], vhi[i][3]}; \
                        o[0] = __builtin_amdgcn_mfma_f32_32x32x16_bf16(pa[i], vf, o[0], 0, 0, 0); } \
                    A_SCHED; \
                    { LAS const unsigned char* vp_ = lds + bcur + 8192 + 4096 + vbl; asm volatile("" : "+v"(vp_)); \
                      _Pragma("unroll") for (int i = 0; i < 4; ++i) { vlo[i] = vtr(vp_ + i * 1024); vhi[i] = vtr(vp_ + i * 1024 + 512); } } \
                    if ((T_) + 3 < NT) { *(LAS u32x4*)(lds + bnn + kdst) = kreg; *(LAS u32x4*)(lds + bnn + vdst) = vreg; } \
                    A_SCHED; \
                    _Pragma("unroll") for (int i = 0; i < 4; ++i) { const bf16x8 vf = (bf16x8){vlo[i][0], vlo[i][1], vlo[i][2], vlo[i][3], vhi[i][0], vhi[i][1], vhi[i][2], vhi[i][3]}; \
                        o[1] = __builtin_amdgcn_mfma_f32_32x32x16_bf16(pa[i], vf, o[1], 0, 0, 0); } \
                    if (BAR_) __syncthreads(); \
                    bcur = bnxt; bnxt = (bnxt == 65536u) ? 0u : bnxt + 16384u; bnn = (bnn == 65536u) ? 0u : bnn + 16384u; \
                } while (0)
                for (int t = 0; t < NT; t += 2) {
#define BAR_ false
                    A_STEP(sa0, sa1, sb0, sb1, t);
#undef BAR_
#define BAR_ true
                    A_STEP(sb0, sb1, sa0, sa1, t + 1);
#undef BAR_
                }
#undef A_STEP
#undef A_SCHED
                flash_finish(o, l, wsf, stg, OB + (rowbase + q0) * DM + h * 64, DM, lane);
            }
        } else if (s == 8 && (PHM & 64)) {
            const int nib = S >> 9, nqb = S >> 5;
            LAS unsigned char* wl = lds + wave * 16384;
            float* LSE = (float*)(ws + WS_LSE);
            for (int pass = 0; pass < 2; ++pass) {
            const int ntask = pass == 0 ? nb * 16 * nqb : nb * 16 * nib * 16;
            const int qstep = pass == 0 ? 1 : 16, ubeg = pass == 0 ? 0 : 10, uend = pass == 0 ? 3 : 17;
            for (int wt = gw; wt < ntask; wt += NGW) {
                int tmin, h, b;
                if (pass == 0) { const int qb = wt % nqb, bh = wt / nqb; h = bh & 15; b = bh >> 4; tmin = qb * 32; }
                else { const int rho = wt & 15, ib = (wt >> 4) % nib, bh = (wt >> 4) / nib; h = bh & 15; b = bh >> 4; tmin = rho + 512 * ib; }
                const size_t rowbase = (size_t)b * S;
                const int tq = tmin + qstep * r32;
                const float slope2 = __builtin_amdgcn_exp2f(-0.5f * (float)(h + 1)) * LOG2E;
                const bf16_t* qp = QKV + (rowbase + tq) * NOP + h * 64 + hi * 8;
                bf16x8 qr[4];
#pragma unroll
                for (int d0 = 0; d0 < 4; ++d0) qr[d0] = *(const bf16x8*)(qp + d0 * 16);
                f32x16 o[2]; o[0] = (f32x16){}; o[1] = (f32x16){}; f32x16 negm = (f32x16){}; float mref = 0.f, l = 0.f;
                const int lrow = lane >> 3, ch = lane & 7;
                const int lrowV = 2 * (lane >> 4) + ((lane >> 2) & 1), dhV = (lane >> 3) & 1, cwV = lane & 3;
                const bf16_t* kb = QKV + rowbase * NOP + 1024 + h * 64 + ch * 8;
                const bf16_t* vb = QKV + rowbase * NOP + 2048 + h * 64 + dhV * 32 + cwV * 8;
                u32x4 kr[8], vr[8];
#define DIL_TILE(u, SH, T0) do { const int g_ = (u) < 10 ? 0 : ((u) < 14 ? 1 : 2); SH = 2 * g_; const int tt_ = (u) - (g_ == 0 ? 0 : (g_ == 1 ? 10 : 14)); T0 = tmin - (64 << SH) + ((64 * tt_) << SH); } while (0)
#define DIL_LOADK(SH, T0) do { int lr_ = lrow; asm volatile("" : "+v"(lr_)); _Pragma("unroll") for (int j = 0; j < 8; ++j) { const int tk_ = min(max(T0 + ((lr_ + 8 * j) << SH), 0), S - 1); kr[j] = *(const u32x4*)(kb + (size_t)tk_ * NOP); } } while (0)
#define DIL_LOADV(SH, T0) do { int lr_ = lrowV; asm volatile("" : "+v"(lr_)); _Pragma("unroll") for (int j = 0; j < 8; ++j) { const int tv_ = min(max(T0 + ((lr_ + 8 * j) << SH), 0), S - 1); vr[j] = *(const u32x4*)(vb + (size_t)tv_ * NOP); } } while (0)
                int sh, t0; DIL_TILE(ubeg, sh, t0); DIL_LOADK(sh, t0); DIL_LOADV(sh, t0);
                for (int u = ubeg; u < uend; ++u) {
                    LAS unsigned char* kw = wl + ch * 1024 + (lrow ^ ch) * 16; LAS unsigned char* vw = wl + 8192 + dhV * 4096 + lrowV * 64 + cwV * 16; asm volatile("" : "+v"(kw), "+v"(vw));
#pragma unroll
                    for (int j = 0; j < 8; ++j) { *(LAS u32x4*)(kw + j * 128) = kr[j]; *(LAS u32x4*)(vw + j * 512) = vr[j]; }
                    int tq_ = tq; asm volatile("" : "+v"(tq_));
                    ModDil mod{(float)(tq_ - t0 - ((4 * hi) << sh)), (float)(1 << sh), (float)(64 << sh), slope2, (float)tq_, (float)(tq_ - S), (t0 >= 0) && (t0 + (63 << sh) < S)};
                    bf16x8 pa[4];
                    if (u + 1 < uend) { DIL_TILE(u + 1, sh, t0); DIL_LOADK(sh, t0); }
                    f32x16 s0, s1;
                    qkt2(s0, s1, wl, qr, negm, r32, hi);
                    softmax2<false>(s0, s1, o, negm, mref, l, wsf, lane, mod, pa, s0, s1);
                    asm volatile("" ::: "memory");
                    if (u + 1 < uend) { DIL_LOADV(sh, t0); }
                    pv_lane(o, wl + 8192, pa, lane);
                    asm volatile("" ::: "memory");
                }
#undef DIL_TILE
#undef DIL_LOADK
#undef DIL_LOADV
                flash_finish_c(o, l, mref, wsf, wl, OB + (rowbase + tmin) * DM + h * 64, (size_t)qstep * DM, lane, LSE + (rowbase + tmin) * 16 + h, qstep * 16, pass == 1);
            }
            if (pass == 0) xcd_barrier(xbar);
            }
        }
        if (ph == 0) grid.sync(); else if (ph < 24) xcd_barrier(xbar);
    }
}

#undef KA
extern "C" void kernel_launch(void* const* d_in, const int* in_sizes, int n_in, void* d_out, int out_size, void* d_ws, size_t ws_size, hipStream_t stream) {
    static int grid_blocks = 0;
    if (!grid_blocks) {
        int dev = 0, cus = 0, per_cu = 0;
        hipGetDevice(&dev);
        hipDeviceGetAttribute(&cus, hipDeviceAttributeMultiprocessorCount, dev);
        hipFuncSetAttribute((const void*)fwd_megakernel, hipFuncAttributeMaxDynamicSharedMemorySize, LDS_BYTES);
        hipOccupancyMaxActiveBlocksPerMultiprocessor(&per_cu, (const void*)fwd_megakernel, NTHREADS, LDS_BYTES);
        if (per_cu < 1) per_cu = 1;
        grid_blocks = cus * per_cu;
        if (n_in != 14 || ws_size < WS_END) fprintf(stderr, "kernel_launch: unexpected n_in %d / ws_size %zu\n", n_in, ws_size);
    }
    (void)hipMemsetAsync((char*)d_ws + WS_BAR, 0, 16384, stream);
    Params p{};
    for (int i = 0; i < 14; ++i) p.in[i] = (const float*)d_in[i];
    p.out = (float*)d_out; p.ws = (unsigned char*)d_ws;
    void* args[] = {&p};
    hipError_t e = hipLaunchCooperativeKernel((const void*)fwd_megakernel, dim3(grid_blocks), dim3(NTHREADS), args, LDS_BYTES, stream);
    if (e != hipSuccess) fprintf(stderr, "cooperative launch failed: %s (grid %d)\n", hipGetErrorString(e), grid_blocks);
}
```
